# Optimizing an MI355X kernel written in HIP

```python
import jax, jax.numpy as jnp
from jax import lax
import numpy as np

D_MODEL = 1024
BATCH = 16
SEQ = 2048
DEPTH = 2

GRID_W = 64
CTX_LEN = 256
HEAD_DIM = 64
N_MIXERS = 4
GROUP_WIDTH = D_MODEL // N_MIXERS
GROUP_HEADS = GROUP_WIDTH // HEAD_DIM
WIN_ROWS = 8
WIN_COLS = 16
COL_QBLOCK = 16
COL_KBLOCK = WIN_COLS + COL_QBLOCK
GMLP_CHUNK = 128
MLSTM_CHUNK = 128
CONV_W = 3
FNET_GROUPS = 4
ROPE_THETA = 10000.0
D_FF = 4 * D_MODEL
N_MOD = 6
EPS = 1e-6
NEG_INF = -1e30
N_GATES = 4 * GROUP_HEADS
OFF_A = 0
OFF_B = 3 * GROUP_WIDTH
OFF_C = 5 * GROUP_WIDTH
OFF_D = 9 * GROUP_WIDTH
OFF_G = 10 * GROUP_WIDTH
D_IN = OFF_G + N_GATES

kernel_name = 'hybrid_nat_gmlp_mlstm_fnet_dit_block'


def rms_norm(x, g):
    x32 = x.astype(jnp.float32)
    y = x32 * lax.rsqrt(jnp.mean(x32 * x32, axis=-1, keepdims=True) + EPS)
    return (y * g.astype(jnp.float32)).astype(x.dtype)


def split_heads(x):
    b, t, _ = x.shape
    return x.reshape(b, t, GROUP_HEADS, HEAD_DIM).transpose(0, 2, 1, 3)


def merge_heads(x):
    b, h, t, d = x.shape
    return x.transpose(0, 2, 1, 3).reshape(b, t, h * d)


def sq_relu_mlp(h, w1, w2):
    return jnp.square(jax.nn.relu(h @ w1)) @ w2


def dense_attention(q, k, v):
    s = jnp.einsum('bhqd,bhkd->bhqk', q, k).astype(jnp.float32) * HEAD_DIM ** -0.5
    p = jax.nn.softmax(s, axis=-1).astype(v.dtype)
    return jnp.einsum('bhqk,bhkd->bhqd', p, v)


def neighbourhood_attention(q, k, v, k_ctx, v_ctx, rpb):
    b, h, s, d = q.shape
    rows = s // GRID_W
    wr = min(WIN_ROWS, rows)
    ncb = GRID_W // COL_QBLOCK
    nk = wr * COL_KBLOCK
    r = jnp.arange(rows)
    row_idx = jnp.clip(r - wr // 2, 0, rows - wr)[:, None] + jnp.arange(wr)[None, :]
    c0 = jnp.arange(ncb) * COL_QBLOCK
    col_idx = jnp.clip(c0 - WIN_COLS // 2, 0, GRID_W - COL_KBLOCK)[:, None] + jnp.arange(COL_KBLOCK)[None, :]
    qcol = c0[:, None] + jnp.arange(COL_QBLOCK)[None, :]
    qstart = jnp.clip(qcol - WIN_COLS // 2, 0, GRID_W - WIN_COLS)
    in_win = (col_idx[:, None, :] >= qstart[:, :, None]) & (col_idx[:, None, :] < qstart[:, :, None] + WIN_COLS)
    d_row = row_idx[:, None, None, :, None] - r[:, None, None, None, None]
    d_col = col_idx[None, :, None, None, :] - qcol[None, :, :, None, None]
    bias = rpb[:, d_row + WIN_ROWS - 1, jnp.clip(d_col + WIN_COLS - 1, 0, 2 * WIN_COLS - 2)].astype(jnp.float32)
    bias = jnp.where(in_win[None, None, :, :, None, :], bias, NEG_INF).reshape(h, rows, ncb, COL_QBLOCK, nk)
    qb = q.reshape(b, h, rows, ncb, COL_QBLOCK, d)
    ri = row_idx[:, None, :, None]
    ci = col_idx[None, :, None, :]
    kb = k.reshape(b, h, rows, GRID_W, d)[:, :, ri, ci].reshape(b, h, rows, ncb, nk, d)
    vb = v.reshape(b, h, rows, GRID_W, d)[:, :, ri, ci].reshape(b, h, rows, ncb, nk, d)
    scale = HEAD_DIM ** -0.5
    s_loc = jnp.einsum('bhrcqd,bhrckd->bhrcqk', qb, kb).astype(jnp.float32) * scale + bias
    s_ctx = jnp.einsum('bhrcqd,bhkd->bhrcqk', qb, k_ctx).astype(jnp.float32) * scale
    p = jax.nn.softmax(jnp.concatenate([s_loc, s_ctx], axis=-1), axis=-1).astype(v.dtype)
    out = (jnp.einsum('bhrcqk,bhrckd->bhrcqd', p[..., :nk], vb)
           + jnp.einsum('bhrcqk,bhkd->bhrcqd', p[..., nk:], v_ctx))
    return out.reshape(b, h, s, d)


def spatial_gating(p_uz, w_s, b_s, g_z):
    uz = jax.nn.gelu(p_uz)
    u, z = uz[..., :GROUP_WIDTH], uz[..., GROUP_WIDTH:]
    z = rms_norm(z, g_z)
    b, t, _ = z.shape
    zc = z.reshape(b, t // GMLP_CHUNK, GMLP_CHUNK, GROUP_HEADS, HEAD_DIM)
    mixed = jnp.einsum('hpq,bnqhd->bnphd', w_s, zc) + b_s.T[:, :, None]
    return u * mixed.reshape(b, t, GROUP_WIDTH)


def short_conv(x, w):
    pad = CONV_W // 2
    return lax.conv_general_dilated(x, w[:, None, :].astype(x.dtype), (1,), [(pad, pad)],
                                    dimension_numbers=('NWC', 'WIO', 'NWC'),
                                    feature_group_count=x.shape[-1])


def rope_axis(x, pos):
    m = x.shape[-1] // 2
    inv = ROPE_THETA ** (-jnp.arange(m, dtype=jnp.float32) / m)
    ang = pos.astype(jnp.float32)[:, None] * inv[None, :]
    cos, sin = jnp.cos(ang), jnp.sin(ang)
    x1, x2 = x[..., :m].astype(jnp.float32), x[..., m:].astype(jnp.float32)
    return jnp.concatenate([x1 * cos - x2 * sin, x1 * sin + x2 * cos], axis=-1).astype(x.dtype)


def rope_2d(x, rows, cols):
    half = x.shape[-1] // 2
    return jnp.concatenate([rope_axis(x[..., :half], rows), rope_axis(x[..., half:], cols)], axis=-1)


def mlstm_scan(q, k, v, ig, lf, state, emit):
    b, h, t, d = q.shape
    n_chunks = t // MLSTM_CHUNK

    def to_chunks(a):
        a = a.astype(jnp.float32)
        return jnp.moveaxis(a.reshape(a.shape[:2] + (n_chunks, MLSTM_CHUNK) + a.shape[3:]), 2, 0)

    lower = jnp.tril(jnp.ones((MLSTM_CHUNK, MLSTM_CHUNK), dtype=bool))

    def step(carry, inp):
        c_mem, n_mem, m_mem = carry
        qc, kc, vc, ic, fc = inp
        bcum = jnp.cumsum(fc, axis=-1)
        b_end = bcum[..., -1]
        log_src = b_end[..., None] - bcum + ic
        m_new = jnp.maximum(b_end + m_mem, jnp.max(log_src, axis=-1))
        w_src = jnp.exp(log_src - m_new[..., None])
        decay = jnp.exp(b_end + m_mem - m_new)
        c_new = decay[..., None, None] * c_mem + jnp.einsum('bhs,bhsd,bhse->bhde', w_src, kc, vc)
        n_new = decay[..., None] * n_mem + jnp.einsum('bhs,bhsd->bhd', w_src, kc)
        if not emit:
            return (c_new, n_new, m_new), None
        log_w = jnp.where(lower, bcum[..., :, None] - bcum[..., None, :] + ic[..., None, :], -jnp.inf)
        log_inter = bcum + m_mem[..., None]
        m_t = jnp.maximum(jnp.max(log_w, axis=-1), log_inter)
        w_intra = jnp.einsum('bhtd,bhsd->bhts', qc, kc) * jnp.exp(log_w - m_t[..., None])
        w_inter = jnp.exp(log_inter - m_t)
        num = (jnp.einsum('bhts,bhsd->bhtd', w_intra, vc)
               + w_inter[..., None] * jnp.einsum('bhtd,bhde->bhte', qc, c_mem))
        den = jnp.sum(w_intra, axis=-1) + w_inter * jnp.einsum('bhtd,bhd->bht', qc, n_mem)
        h_out = num / jnp.maximum(jnp.abs(den), jnp.exp(-m_t))[..., None]
        return (c_new, n_new, m_new), h_out

    xs = (to_chunks(q), to_chunks(k), to_chunks(v), to_chunks(ig), to_chunks(lf))
    state, hs = lax.scan(step, state, xs)
    if not emit:
        return None, state
    return jnp.moveaxis(hs, 0, 2).reshape(b, h, t, d).astype(q.dtype), state


def mlstm_prep(p, w_conv, b_gate, pos):
    gw = GROUP_WIDTH
    qk = jax.nn.silu(short_conv(p[..., OFF_C:OFF_C + 2 * gw], w_conv))
    q = split_heads(qk[..., :gw])
    k = split_heads(qk[..., gw:])
    if pos is not None:
        q = rope_2d(q, pos[0], pos[1])
        k = rope_2d(k, pos[0], pos[1])
    k = k * HEAD_DIM ** -0.5
    v = split_heads(p[..., OFF_C + 2 * gw:OFF_C + 3 * gw])
    g = (p[..., OFF_G:OFF_G + N_GATES].astype(jnp.float32) + b_gate.astype(jnp.float32)).transpose(0, 2, 1)
    return q, k, v, g


def mlstm_bidirectional(ctx_in, lat_in, emit_ctx):
    qc, kc, vc, gc = ctx_in
    ql, kl, vl, gl = lat_in
    b = ql.shape[0]
    zero = (jnp.zeros((b, GROUP_HEADS, HEAD_DIM, HEAD_DIM), jnp.float32),
            jnp.zeros((b, GROUP_HEADS, HEAD_DIM), jnp.float32),
            jnp.zeros((b, GROUP_HEADS), jnp.float32))

    def run(rev):
        o = 2 * GROUP_HEADS * int(rev)
        flip = (lambda a: jnp.flip(a, axis=2)) if rev else (lambda a: a)
        ig_c, lf_c = gc[:, o:o + GROUP_HEADS], jax.nn.log_sigmoid(gc[:, o + GROUP_HEADS:o + 2 * GROUP_HEADS])
        ig_l, lf_l = gl[:, o:o + GROUP_HEADS], jax.nn.log_sigmoid(gl[:, o + GROUP_HEADS:o + 2 * GROUP_HEADS])
        h_c, st = mlstm_scan(flip(qc), flip(kc), flip(vc), flip(ig_c), flip(lf_c), zero, emit_ctx)
        h_l, _ = mlstm_scan(flip(ql), flip(kl), flip(vl), flip(ig_l), flip(lf_l), st, True)
        return (flip(h_c) if emit_ctx else None), flip(h_l)

    hc_f, hl_f = run(False)
    hc_b, hl_b = run(True)
    h_ctx = hc_f + hc_b if emit_ctx else None
    return h_ctx, hl_f + hl_b


def head_layer_norm(x, g):
    b, t, _ = x.shape
    xh = x.astype(jnp.float32).reshape(b, t, GROUP_HEADS, HEAD_DIM)
    mu = jnp.mean(xh, axis=-1, keepdims=True)
    var = jnp.mean(jnp.square(xh - mu), axis=-1, keepdims=True)
    y = ((xh - mu) * lax.rsqrt(var + EPS)).reshape(b, t, GROUP_WIDTH) * g.astype(jnp.float32)
    return y.astype(x.dtype)


def mlstm_output(h, p, g):
    o = jax.nn.sigmoid(p[..., OFF_C + 3 * GROUP_WIDTH:OFF_C + 4 * GROUP_WIDTH])
    return o * head_layer_norm(merge_heads(h), g)


def fourier_mix(f, w_fnet):
    b, t, _ = f.shape
    fg = f.astype(jnp.float32).reshape(b, t, FNET_GROUPS, GROUP_WIDTH // FNET_GROUPS)
    spec = jnp.fft.fft2(fg, axes=(1, 3), norm='ortho').real
    return spec.reshape(b, t, GROUP_WIDTH).astype(f.dtype) @ w_fnet


def token_mixers(h_lat, h_ctx, pos, w_in, b_gate, w_conv_qk, rpb, w_spatial, b_spatial,
                 g_gmlp, g_mlstm, w_fnet, w_out, with_ctx_out):
    gw = GROUP_WIDTH
    p_lat = h_lat @ w_in
    p_ctx = h_ctx @ w_in
    qa_l, ka_l, va_l = [split_heads(p_lat[..., OFF_A + i * gw:OFF_A + (i + 1) * gw]) for i in range(3)]
    qa_c, ka_c, va_c = [split_heads(p_ctx[..., OFF_A + i * gw:OFF_A + (i + 1) * gw]) for i in range(3)]
    a_lat = merge_heads(neighbourhood_attention(qa_l, ka_l, va_l, ka_c, va_c, rpb))
    b_lat = spatial_gating(p_lat[..., OFF_B:OFF_B + 2 * gw], w_spatial, b_spatial, g_gmlp)
    c_in_ctx = mlstm_prep(p_ctx, w_conv_qk, b_gate, None)
    c_in_lat = mlstm_prep(p_lat, w_conv_qk, b_gate, pos)
    hm_ctx, hm_lat = mlstm_bidirectional(c_in_ctx, c_in_lat, with_ctx_out)
    c_lat = mlstm_output(hm_lat, p_lat, g_mlstm)
    d_lat = fourier_mix(p_lat[..., OFF_D:OFF_D + gw], w_fnet)
    y_lat = jnp.concatenate([a_lat, b_lat, c_lat, d_lat], axis=-1) @ w_out
    if not with_ctx_out:
        return y_lat, None
    a_ctx = merge_heads(dense_attention(qa_c, ka_c, va_c))
    b_ctx = spatial_gating(p_ctx[..., OFF_B:OFF_B + 2 * gw], w_spatial, b_spatial, g_gmlp)
    c_ctx_out = mlstm_output(hm_ctx, p_ctx, g_mlstm)
    d_ctx = fourier_mix(p_ctx[..., OFF_D:OFF_D + gw], w_fnet)
    y_ctx = jnp.concatenate([a_ctx, b_ctx, c_ctx_out, d_ctx], axis=-1) @ w_out
    return y_lat, y_ctx


def setup_inputs(seed: int = 0) -> dict:
    key = jax.random.key(seed)
    ks = jax.random.split(key, 21)
    nrm = jax.random.normal
    gate_base = jnp.tile(jnp.concatenate([jnp.zeros((GROUP_HEADS,), jnp.float32),
                                          jnp.linspace(3.0, 6.0, GROUP_HEADS, dtype=jnp.float32)]), 2)
    return {
        'x': nrm(ks[0], (BATCH, SEQ, D_MODEL), jnp.float32),
        'c': nrm(ks[1], (BATCH, D_MODEL), jnp.float32),
        'ctx': nrm(ks[2], (BATCH, CTX_LEN, D_MODEL), jnp.float32),
        'c_ctx': nrm(ks[3], (D_MODEL,), jnp.float32),
        'w_ada': nrm(ks[4], (DEPTH, D_MODEL, N_MOD * D_MODEL), jnp.float32) * (0.5 * D_MODEL ** -0.5),
        'b_ada': 0.02 * nrm(ks[5], (DEPTH, N_MOD * D_MODEL), jnp.float32),
        'g_norm_mix': 1.0 + 0.05 * nrm(ks[6], (DEPTH, D_MODEL), jnp.float32),
        'g_norm_ffn': 1.0 + 0.05 * nrm(ks[7], (DEPTH, D_MODEL), jnp.float32),
        'w_in': nrm(ks[8], (DEPTH, D_MODEL, D_IN), jnp.float32) * D_MODEL ** -0.5,
        'b_gate': gate_base[None, :] + 0.1 * nrm(ks[9], (DEPTH, N_GATES), jnp.float32),
        'w_conv_qk': nrm(ks[10], (DEPTH, CONV_W, 2 * GROUP_WIDTH), jnp.float32) * CONV_W ** -0.5,
        'rpb': 0.2 * nrm(ks[11], (DEPTH, GROUP_HEADS, 2 * WIN_ROWS - 1, 2 * WIN_COLS - 1), jnp.float32),
        'w_spatial': nrm(ks[12], (DEPTH, GROUP_HEADS, GMLP_CHUNK, GMLP_CHUNK), jnp.float32) * GMLP_CHUNK ** -0.5,
        'b_spatial': 1.0 + 0.1 * nrm(ks[13], (DEPTH, GROUP_HEADS, GMLP_CHUNK), jnp.float32),
        'g_gmlp': 1.0 + 0.05 * nrm(ks[14], (DEPTH, GROUP_WIDTH), jnp.float32),
        'g_mlstm': 1.0 + 0.05 * nrm(ks[15], (DEPTH, GROUP_WIDTH), jnp.float32),
        'w_fnet': nrm(ks[16], (DEPTH, GROUP_WIDTH, GROUP_WIDTH), jnp.float32) * GROUP_WIDTH ** -0.5,
        'w_out': nrm(ks[17], (DEPTH, D_MODEL, D_MODEL), jnp.float32) * D_MODEL ** -0.5,
        'w_ff1': nrm(ks[18], (DEPTH, D_MODEL, D_FF), jnp.float32) * D_MODEL ** -0.5,
        'w_ff2': nrm(ks[19], (DEPTH, D_FF, D_MODEL), jnp.float32) * D_FF ** -0.5,
        'g_final': 1.0 + 0.05 * nrm(ks[20], (D_MODEL,), jnp.float32),
    }


def reference(x, c, ctx, c_ctx, w_ada, b_ada, g_norm_mix, g_norm_ffn, w_in, b_gate, w_conv_qk, rpb,
              w_spatial, b_spatial, g_gmlp, g_mlstm, w_fnet, w_out, w_ff1, w_ff2, g_final):
    seq = x.shape[1]
    t = jnp.arange(seq)
    pos = ((t // GRID_W).astype(jnp.float32), (t % GRID_W).astype(jnp.float32))
    for l in range(DEPTH):
        last = l == DEPTH - 1
        mod_lat = (jax.nn.silu(c) @ w_ada[l] + b_ada[l]).reshape(c.shape[0], N_MOD, 1, D_MODEL)
        mod_ctx = (jax.nn.silu(c_ctx) @ w_ada[l] + b_ada[l]).reshape(N_MOD, D_MODEL)
        h_lat = rms_norm(x, g_norm_mix[l]) * (1.0 + mod_lat[:, 1]) + mod_lat[:, 0]
        h_ctx = rms_norm(ctx, g_norm_mix[l]) * (1.0 + mod_ctx[1]) + mod_ctx[0]
        y_lat, y_ctx = token_mixers(h_lat, h_ctx, pos, w_in[l], b_gate[l], w_conv_qk[l], rpb[l],
                                    w_spatial[l], b_spatial[l], g_gmlp[l], g_mlstm[l], w_fnet[l],
                                    w_out[l], not last)
        x = x + mod_lat[:, 2] * y_lat
        h_lat = rms_norm(x, g_norm_ffn[l]) * (1.0 + mod_lat[:, 4]) + mod_lat[:, 3]
        x = x + mod_lat[:, 5] * sq_relu_mlp(h_lat, w_ff1[l], w_ff2[l])
        if not last:
            ctx = ctx + mod_ctx[2] * y_ctx
            h_ctx = rms_norm(ctx, g_norm_ffn[l]) * (1.0 + mod_ctx[4]) + mod_ctx[3]
            ctx = ctx + mod_ctx[5] * sq_relu_mlp(h_ctx, w_ff1[l], w_ff2[l])
    return rms_norm(x, g_final)
```

```cpp
#include <hip/hip_runtime.h>
#include <hip/hip_cooperative_groups.h>
#include <cstdio>
#include <cstdint>
namespace cg = cooperative_groups;

typedef unsigned short bf16_t;
typedef short bf16x8 __attribute__((ext_vector_type(8)));
typedef short bf16x4 __attribute__((ext_vector_type(4)));
typedef float f32x4 __attribute__((ext_vector_type(4)));
typedef unsigned u32x4 __attribute__((ext_vector_type(4)));
typedef unsigned u32x2 __attribute__((ext_vector_type(2)));

constexpr int D = 1024, NB = 16, SEQ = 2048, CTXL = 256;
constexpr int NLAT = NB * SEQ, NCTX = NB * CTXL, NTOK = NLAT + NCTX;
constexpr int NPAD = 2944, PW = 1792, DFF = 4096, DIN = 2576;
constexpr int NU = 128 * 18;
constexpr int NTHREADS = 256;
constexpr int LDS_BYTES = 73728;

constexpr size_t al256(size_t x) { return (x + 255) & ~(size_t)255; }
constexpr size_t OFF_WIN = 0;
constexpr size_t OFF_WOUT = OFF_WIN + al256((size_t)2 * NPAD * 1024 * 2);
constexpr size_t OFF_W1 = OFF_WOUT + al256((size_t)2 * 1024 * 1024 * 2);
constexpr size_t OFF_W2 = OFF_W1 + al256((size_t)2 * 4096 * 1024 * 2);
constexpr size_t OFF_WSP = OFF_W2 + al256((size_t)2 * 4096 * 1024 * 2);
constexpr size_t OFF_TABL = OFF_WSP + al256((size_t)2 * 4 * 128 * 128 * 2);
constexpr size_t OFF_TABC = OFF_TABL + al256((size_t)2048 * 4096 * 2);
constexpr size_t OFF_MOD = OFF_TABC + al256((size_t)256 * 512 * 2);
constexpr size_t OFF_CTXRES = OFF_MOD + al256((size_t)2 * 17 * 6144 * 4);
constexpr size_t OFF_HM = OFF_CTXRES + al256((size_t)NCTX * 1024 * 4);
constexpr size_t OFF_R = OFF_HM + al256((size_t)NTOK * 1024 * 2);
constexpr size_t OFF_P = OFF_R;
constexpr size_t OFF_G = OFF_P + al256((size_t)NTOK * PW * 2);
constexpr size_t OFF_VTA = OFF_G + al256((size_t)NTOK * 16 * 4);
constexpr size_t OFF_VTC = OFF_VTA + al256((size_t)NTOK * 256 * 2);
constexpr size_t OFF_FT = OFF_VTC + al256((size_t)NTOK * 256 * 2);
constexpr size_t OFF_QC = OFF_FT + al256((size_t)NTOK * 256 * 2 * 2);
constexpr size_t OFF_KC = OFF_QC + al256((size_t)NTOK * 256 * 2);
constexpr size_t OFF_KCT = OFF_KC + al256((size_t)NTOK * 256 * 2);
constexpr size_t OFF_UB = OFF_KCT + al256((size_t)NTOK * 256 * 2);
constexpr size_t OFF_USC = OFF_UB + al256((size_t)NU * 5120 * 4);
constexpr size_t OFF_SB = OFF_USC + al256((size_t)NU * 2 * 4);
constexpr size_t OFF_MB = OFF_SB + al256((size_t)NU * 5120 * 2);
constexpr size_t OFF_BAR = OFF_MB + al256((size_t)NU * 4);
constexpr size_t OFF_END = OFF_BAR + al256((size_t)3520 * 4);
constexpr size_t OFF_HID = OFF_R;
constexpr size_t OFF_CPART = OFF_HID + al256((size_t)NTOK * 4096 * 2);
static_assert(OFF_CPART + (size_t)NCTX * 1024 * 4 <= OFF_BAR, "context partial scratch must fit behind the hid overlay");
static_assert(OFF_HID + (size_t)NTOK * 4096 * 2 <= OFF_END, "hid overlay must fit");
static_assert(OFF_END <= (size_t)536870912, "workspace too large");

struct Params {
    const float *x, *c, *ctx, *c_ctx, *w_ada, *b_ada, *g_mix, *g_ffn, *w_in, *b_gate, *w_conv, *rpb, *w_sp, *b_sp,
        *g_gmlp, *g_mlstm, *w_fnet, *w_out, *w_ff1, *w_ff2, *g_final;
    float* out;
    char* ws;
};

__device__ __forceinline__ float shx(float v, int o, int lane) { return __int_as_float(__builtin_amdgcn_ds_bpermute((lane ^ o) << 2, __float_as_int(v))); }
__device__ __forceinline__ float shi(float v, int src) { return __int_as_float(__builtin_amdgcn_ds_bpermute((src & 63) << 2, __float_as_int(v))); }
__device__ __forceinline__ int get_tid() { int t = threadIdx.x; asm volatile("" : "+v"(t)); return t; }
__device__ __forceinline__ bf16_t f2bf(float f) { return __builtin_bit_cast(unsigned short, (__bf16)f); }
__device__ __forceinline__ float bf2f(bf16_t b) { return __uint_as_float(((unsigned)b) << 16); }
__device__ __forceinline__ float bfs2f(short b) { return __uint_as_float(((unsigned)(unsigned short)b) << 16); }
typedef __bf16 bf16v2_t __attribute__((ext_vector_type(2)));
__device__ __forceinline__ unsigned pack2(float lo, float hi) { bf16v2_t v; v[0] = (__bf16)lo; v[1] = (__bf16)hi; return __builtin_bit_cast(unsigned, v); }
__device__ __forceinline__ float gelu_tanh(float x) {
    float u = 0.7978845608028654f * (x + 0.044715f * x * x * x);
    float t = 1.f - 2.f * __builtin_amdgcn_rcpf(__expf(2.f * u) + 1.f);
    return 0.5f * x * (1.f + t);
}
__device__ __forceinline__ float sigmoidf_(float x) { return __builtin_amdgcn_rcpf(1.f + __expf(-x)); }
__device__ __forceinline__ float logsigmoidf_(float x) { return fminf(x, 0.f) - log1pf(__expf(-fabsf(x))); }
__device__ __forceinline__ f32x4 mfma16(bf16x8 a, bf16x8 b, f32x4 c) { return __builtin_amdgcn_mfma_f32_16x16x32_bf16(a, b, c, 0, 0, 0); }
__device__ __forceinline__ bf16x8 cat4(bf16x4 a, bf16x4 b) { return __builtin_shufflevector(a, b, 0, 1, 2, 3, 4, 5, 6, 7); }
__device__ __forceinline__ bf16x8 packw(f32x4 a, f32x4 b) {
    bf16x8 r;
    r[0] = (short)f2bf(a[0]); r[1] = (short)f2bf(a[1]); r[2] = (short)f2bf(a[2]); r[3] = (short)f2bf(a[3]);
    r[4] = (short)f2bf(b[0]); r[5] = (short)f2bf(b[1]); r[6] = (short)f2bf(b[2]); r[7] = (short)f2bf(b[3]);
    return r;
}
struct SeqInfo { size_t base; int T; int t; int b; };
__device__ __forceinline__ SeqInfo seqinfo(int tok) {
    SeqInfo s;
    if (tok < NLAT) { s.b = tok >> 11; s.t = tok & 2047; s.T = 2048; s.base = (size_t)s.b * 256 * 2048; }
    else { int j = tok - NLAT; s.b = j >> 8; s.t = j & 255; s.T = 256; s.base = (size_t)NLAT * 256 + (size_t)s.b * 256 * 256; }
    return s;
}

template <bool SWAP, class Epi>
__device__ __forceinline__ void gemm_tile(const bf16_t* __restrict__ A, size_t lda, const bf16_t* __restrict__ Bt, size_t ldb,
                                          int K, int m0, int n0, char* lds, const Epi& epi) {
    const int tid = get_tid(), lane = tid & 63, wid = tid >> 6, wr = wid >> 1, wc = wid & 1, fr = lane & 15, fq = lane >> 4;
    f32x4 acc[4][4];
#pragma unroll
    for (int i = 0; i < 4; ++i)
#pragma unroll
        for (int j = 0; j < 4; ++j) acc[i][j] = (f32x4){0.f, 0.f, 0.f, 0.f};
    const int lr = tid >> 3, lc = tid & 7;
    const bf16_t* ag = A + (size_t)(m0 + lr) * lda + lc * 8;
    const bf16_t* bg = Bt + (size_t)(n0 + lr) * ldb + lc * 8;
    char* wdst = lds + lr * 128 + ((lc ^ ((lr >> 1) & 7)) << 4);
    const int roff = (fq ^ (fr >> 1)) * 16;
    const char* ardb = lds + (wr * 64 + fr) * 128;
    const char* brdb = lds + 16384 + (wc * 64 + fr) * 128;
    u32x4 ra[4], rb[4];
#pragma unroll
    for (int j = 0; j < 4; ++j) { ra[j] = *(const u32x4*)(ag + (size_t)j * 32 * lda); rb[j] = *(const u32x4*)(bg + (size_t)j * 32 * ldb); }
    for (int k0 = 0; k0 < K; k0 += 64) {
        __syncthreads();
#pragma unroll
        for (int j = 0; j < 4; ++j) { *(u32x4*)(wdst + j * 4096) = ra[j]; *(u32x4*)(wdst + 16384 + j * 4096) = rb[j]; }
        __syncthreads();
        if (k0 + 64 < K) {
#pragma unroll
            for (int j = 0; j < 4; ++j) {
                ra[j] = *(const u32x4*)(ag + (size_t)j * 32 * lda + k0 + 64);
                rb[j] = *(const u32x4*)(bg + (size_t)j * 32 * ldb + k0 + 64);
            }
        }
#pragma unroll
        for (int ks = 0; ks < 2; ++ks) {
            bf16x8 af[4], bf[4];
            const int ko = roff ^ (ks * 64);
#pragma unroll
            for (int i = 0; i < 4; ++i) af[i] = *(const bf16x8*)(ardb + i * 2048 + ko);
#pragma unroll
            for (int j = 0; j < 4; ++j) bf[j] = *(const bf16x8*)(brdb + j * 2048 + ko);
#pragma unroll
            for (int i = 0; i < 4; ++i)
#pragma unroll
                for (int j = 0; j < 4; ++j) {
                    if (SWAP) acc[i][j] = mfma16(bf[j], af[i], acc[i][j]);
                    else acc[i][j] = mfma16(af[i], bf[j], acc[i][j]);
                }
        }
    }
#pragma unroll
    for (int i = 0; i < 4; ++i)
#pragma unroll
        for (int j = 0; j < 4; ++j) {
            if (SWAP) epi.horiz(m0 + wr * 64 + i * 16 + fr, n0 + wc * 64 + j * 16 + fq * 4, acc[i][j]);
            else epi.vert(m0 + wr * 64 + i * 16 + fq * 4, n0 + wc * 64 + j * 16 + fr, acc[i][j]);
        }
}

__device__ __forceinline__ void dft_sym_tile(const bf16_t* __restrict__ Tab, const bf16_t* __restrict__ FTb, bf16_t* __restrict__ MIX,
                                             int b, int m0, int n0, float scale, char* lds) {
    const int tid = get_tid(), lane = tid & 63, wid = tid >> 6, wr = wid >> 1, wc = wid & 1, fr = lane & 15, fq = lane >> 4;
    f32x4 acc[4][4];
    u32x2 cpk[4][4];
#pragma unroll
    for (int i = 0; i < 4; ++i)
#pragma unroll
        for (int j = 0; j < 4; ++j) acc[i][j] = (f32x4){0.f, 0.f, 0.f, 0.f};
    const int lr = tid >> 3, lc = tid & 7;
    const bf16_t* ag = Tab + (size_t)(m0 + lr) * 4096 + lc * 8;
    const bf16_t* bg = FTb + (size_t)(n0 + lr) * 4096 + lc * 8;
    char* wdst = lds + lr * 128 + ((lc ^ ((lr >> 1) & 7)) << 4);
    const int roff = (fq ^ (fr >> 1)) * 16;
    const char* ardb = lds + (wr * 64 + fr) * 128;
    const char* brdb = lds + 16384 + (wc * 64 + fr) * 128;
    u32x4 ra[4], rb[4];
#pragma unroll
    for (int j = 0; j < 4; ++j) { ra[j] = *(const u32x4*)(ag + (size_t)j * 32 * 4096); rb[j] = *(const u32x4*)(bg + (size_t)j * 32 * 4096); }
#pragma unroll 1
    for (int half = 0; half < 2; ++half) {
#pragma unroll 1
        for (int k0 = half * 2048; k0 < half * 2048 + 2048; k0 += 64) {
            __syncthreads();
#pragma unroll
            for (int j = 0; j < 4; ++j) { *(u32x4*)(wdst + j * 4096) = ra[j]; *(u32x4*)(wdst + 16384 + j * 4096) = rb[j]; }
            __syncthreads();
            if (k0 + 64 < 4096) {
#pragma unroll
                for (int j = 0; j < 4; ++j) {
                    ra[j] = *(const u32x4*)(ag + (size_t)j * 32 * 4096 + k0 + 64);
                    rb[j] = *(const u32x4*)(bg + (size_t)j * 32 * 4096 + k0 + 64);
                }
            }
#pragma unroll
            for (int ks = 0; ks < 2; ++ks) {
                bf16x8 af[4], bf[4];
                const int ko = roff ^ (ks * 64);
#pragma unroll
                for (int i = 0; i < 4; ++i) af[i] = *(const bf16x8*)(ardb + i * 2048 + ko);
#pragma unroll
                for (int j = 0; j < 4; ++j) bf[j] = *(const bf16x8*)(brdb + j * 2048 + ko);
#pragma unroll
                for (int i = 0; i < 4; ++i)
#pragma unroll
                    for (int j = 0; j < 4; ++j) acc[i][j] = mfma16(bf[j], af[i], acc[i][j]);
            }
        }
        if (half == 0) {
#pragma unroll
            for (int i = 0; i < 4; ++i)
#pragma unroll
                for (int j = 0; j < 4; ++j) {
                    cpk[i][j][0] = pack2(acc[i][j][0], acc[i][j][1]); cpk[i][j][1] = pack2(acc[i][j][2], acc[i][j][3]);
                    acc[i][j] = (f32x4){0.f, 0.f, 0.f, 0.f};
                }
        }
    }
#pragma unroll
    for (int i = 0; i < 4; ++i)
#pragma unroll
        for (int j = 0; j < 4; ++j) {
            const int m = m0 + wr * 64 + i * 16 + fr, n = n0 + wc * 64 + j * 16 + fq * 4;
            const f32x4 sn = acc[i][j];
            f32x4 c;
            c[0] = bf2f((bf16_t)(cpk[i][j][0] & 0xffffu)); c[1] = bf2f((bf16_t)(cpk[i][j][0] >> 16));
            c[2] = bf2f((bf16_t)(cpk[i][j][1] & 0xffffu)); c[3] = bf2f((bf16_t)(cpk[i][j][1] >> 16));
            u32x2 w0; w0[0] = pack2((c[0] + sn[0]) * scale, (c[1] + sn[1]) * scale); w0[1] = pack2((c[2] + sn[2]) * scale, (c[3] + sn[3]) * scale);
            *(u32x2*)(MIX + (size_t)(b * 2048 + m) * 1024 + 768 + n) = w0;
            if (m > 0) {
                u32x2 w1; w1[0] = pack2((c[0] - sn[0]) * scale, (c[1] - sn[1]) * scale); w1[1] = pack2((c[2] - sn[2]) * scale, (c[3] - sn[3]) * scale);
                *(u32x2*)(MIX + (size_t)(b * 2048 + 2048 - m) * 1024 + 768 + n) = w1;
            }
        }
}
__device__ __forceinline__ void dft_mid_task(const bf16_t* __restrict__ FT, bf16_t* __restrict__ MIX, int q, float scale) {
    const int tid = get_tid(), lane = tid & 63;
    const int b = q >> 2, ch = (q & 3) * 64 + (tid >> 2), part = tid & 3;
    const bf16_t* src = FT + (size_t)b * 256 * 4096 + (size_t)ch * 4096 + part * 512;
    float se = 0.f, so = 0.f;
#pragma unroll 1
    for (int c0 = 0; c0 < 64; c0 += 16) {
        bf16x8 v[16];
#pragma unroll
        for (int i = 0; i < 16; ++i) v[i] = *(const bf16x8*)(src + (c0 + i) * 8);
#pragma unroll
        for (int i = 0; i < 16; ++i)
#pragma unroll
            for (int e = 0; e < 8; e += 2) { se += bfs2f(v[i][e]); so += bfs2f(v[i][e + 1]); }
    }
    float d = se - so;
    d += shx(d, 1, lane);
    d += shx(d, 2, lane);
    if (part == 0) MIX[(size_t)(b * 2048 + 1024) * 1024 + 768 + ch] = f2bf(d * scale);
}

template <bool SWAP, class Epi>
__device__ __forceinline__ void gemm_tile_big(const bf16_t* __restrict__ A, size_t lda, const bf16_t* __restrict__ Bt, size_t ldb,
                                              int K, int m0, int n0, char* lds, const Epi& epi) {
    const int tid = get_tid(), lane = tid & 63, wid = tid >> 6, wr = wid >> 1, wc = wid & 1, fr = lane & 15, fq = lane >> 4;
    f32x4 acc[8][4];
#pragma unroll
    for (int i = 0; i < 8; ++i)
#pragma unroll
        for (int j = 0; j < 4; ++j) acc[i][j] = (f32x4){0.f, 0.f, 0.f, 0.f};
    const int lr = tid >> 2, lc = tid & 3;
    const bf16_t* ag = A + (size_t)(m0 + lr) * lda + lc * 8;
    const bf16_t* bg = Bt + (size_t)(n0 + lr) * ldb + lc * 8;
    char* wdst = lds + lr * 64 + ((lc ^ ((-(lr >> 2)) & 3)) << 4);
    const int roff = (fq ^ ((-(fr >> 2)) & 3)) << 4;
    const char* ardb = lds + (wr * 128 + fr) * 64 + roff;
    const char* brdb = lds + 16384 + (wc * 64 + fr) * 64 + roff;
    u32x4 ra[4], rb[2];
#pragma unroll
    for (int j = 0; j < 4; ++j) ra[j] = *(const u32x4*)(ag + (size_t)j * 64 * lda);
#pragma unroll
    for (int j = 0; j < 2; ++j) rb[j] = *(const u32x4*)(bg + (size_t)j * 64 * ldb);
    for (int k0 = 0; k0 < K; k0 += 32) {
        __syncthreads();
#pragma unroll
        for (int j = 0; j < 4; ++j) *(u32x4*)(wdst + j * 4096) = ra[j];
#pragma unroll
        for (int j = 0; j < 2; ++j) *(u32x4*)(wdst + 16384 + j * 4096) = rb[j];
        __syncthreads();
        if (k0 + 32 < K) {
#pragma unroll
            for (int j = 0; j < 4; ++j) ra[j] = *(const u32x4*)(ag + (size_t)j * 64 * lda + k0 + 32);
#pragma unroll
            for (int j = 0; j < 2; ++j) rb[j] = *(const u32x4*)(bg + (size_t)j * 64 * ldb + k0 + 32);
        }
        bf16x8 bf[4];
#pragma unroll
        for (int j = 0; j < 4; ++j) bf[j] = *(const bf16x8*)(brdb + j * 1024);
#pragma unroll
        for (int i = 0; i < 8; ++i) {
            const bf16x8 af = *(const bf16x8*)(ardb + i * 1024);
#pragma unroll
            for (int j = 0; j < 4; ++j) {
                if (SWAP) acc[i][j] = mfma16(bf[j], af, acc[i][j]);
                else acc[i][j] = mfma16(af, bf[j], acc[i][j]);
            }
        }
    }
#pragma unroll
    for (int i = 0; i < 8; ++i)
#pragma unroll
        for (int j = 0; j < 4; ++j) {
            if (SWAP) epi.horiz(m0 + wr * 128 + i * 16 + fr, n0 + wc * 64 + j * 16 + fq * 4, acc[i][j]);
            else epi.vert(m0 + wr * 128 + i * 16 + fq * 4, n0 + wc * 64 + j * 16 + fr, acc[i][j]);
        }
}

template <bool SWAP, class Epi>
__device__ __forceinline__ void gemm_tile_big64(const bf16_t* __restrict__ A, size_t lda, const bf16_t* __restrict__ Bt, size_t ldb,
                                                int K, int m0, int n0, char* lds, const Epi& epi) {
    const int tid = get_tid(), lane = tid & 63, wid = tid >> 6, wr = wid >> 1, wc = wid & 1, fr = lane & 15, fq = lane >> 4;
    f32x4 acc[8][4];
#pragma unroll
    for (int i = 0; i < 8; ++i)
#pragma unroll
        for (int j = 0; j < 4; ++j) acc[i][j] = (f32x4){0.f, 0.f, 0.f, 0.f};
    const int lr = tid >> 3, lc = tid & 7;
    const bf16_t* ag = A + (size_t)(m0 + lr) * lda + lc * 8;
    const bf16_t* bg = Bt + (size_t)(n0 + lr) * ldb + lc * 8;
    char* wdst = lds + lr * 128 + ((lc ^ ((lr >> 1) & 7)) << 4);
    const int roff = (fq ^ (fr >> 1)) * 16;
    const char* ardb = lds + (wr * 128 + fr) * 128;
    const char* brdb = lds + 32768 + (wc * 64 + fr) * 128;
    u32x4 ra[8], rb[4];
#pragma unroll
    for (int j = 0; j < 8; ++j) ra[j] = *(const u32x4*)(ag + (size_t)j * 32 * lda);
#pragma unroll
    for (int j = 0; j < 4; ++j) rb[j] = *(const u32x4*)(bg + (size_t)j * 32 * ldb);
    for (int k0 = 0; k0 < K; k0 += 64) {
        __syncthreads();
#pragma unroll
        for (int j = 0; j < 8; ++j) *(u32x4*)(wdst + j * 4096) = ra[j];
#pragma unroll
        for (int j = 0; j < 4; ++j) *(u32x4*)(wdst + 32768 + j * 4096) = rb[j];
        __syncthreads();
        if (k0 + 64 < K) {
#pragma unroll
            for (int j = 0; j < 8; ++j) ra[j] = *(const u32x4*)(ag + (size_t)j * 32 * lda + k0 + 64);
#pragma unroll
            for (int j = 0; j < 4; ++j) rb[j] = *(const u32x4*)(bg + (size_t)j * 32 * ldb + k0 + 64);
        }
#pragma unroll
        for (int ks = 0; ks < 2; ++ks) {
            const int ko = roff ^ (ks * 64);
            bf16x8 bf[4];
#pragma unroll
            for (int j = 0; j < 4; ++j) bf[j] = *(const bf16x8*)(brdb + j * 2048 + ko);
#pragma unroll
            for (int i = 0; i < 8; ++i) {
                const bf16x8 af = *(const bf16x8*)(ardb + i * 2048 + ko);
#pragma unroll
                for (int j = 0; j < 4; ++j) {
                    if (SWAP) acc[i][j] = mfma16(bf[j], af, acc[i][j]);
                    else acc[i][j] = mfma16(af, bf[j], acc[i][j]);
                }
            }
        }
    }
#pragma unroll
    for (int i = 0; i < 8; ++i)
#pragma unroll
        for (int j = 0; j < 4; ++j) {
            if (SWAP) epi.horiz(m0 + wr * 128 + i * 16 + fr, n0 + wc * 64 + j * 16 + fq * 4, acc[i][j]);
            else epi.vert(m0 + wr * 128 + i * 16 + fq * 4, n0 + wc * 64 + j * 16 + fr, acc[i][j]);
        }
}

typedef __attribute__((address_space(3))) void* lds_ptr_t;
__device__ __forceinline__ void glds16(const void* g, unsigned lds_base) {
    unsigned sv;
    asm volatile("s_mov_b32 %0, m0\n\ts_mov_b32 m0, %2\n\ts_nop 0\n\tglobal_load_lds_dwordx4 %1, off\n\ts_mov_b32 m0, %0" : "=&s"(sv) : "v"(g), "s"(lds_base) : "memory");
}
template <int MI, bool SWAP, class Epi>
__device__ __forceinline__ void gemm_tile_ring(const bf16_t* __restrict__ A, size_t lda, const bf16_t* __restrict__ Bt, size_t ldb,
                                               int K, int m0, int n0, char* lds, const Epi& epi,
                                               bool prefetched, bool hasNext, int nm0, int nn0) {
    const int tid = get_tid(), lane = tid & 63, wid = __builtin_amdgcn_readfirstlane(tid >> 6), wr = wid >> 1, wc = wid & 1, fr = lane & 15, fq = lane >> 4;
    f32x4 acc[MI][4];
#pragma unroll
    for (int i = 0; i < MI; ++i)
#pragma unroll
        for (int j = 0; j < 4; ++j) acc[i][j] = (f32x4){0.f, 0.f, 0.f, 0.f};
    const int sg = (-(lane >> 4)) & 3, srow = lane >> 2, sc = ((lane & 3) ^ sg) * 8;
    const bf16_t* ag = A + (size_t)(m0 + wid * (MI * 8) + srow) * lda + sc;
    const bf16_t* bg = Bt + (size_t)(n0 + wid * 32 + srow) * ldb + sc;
    const unsigned lbase = (unsigned)(size_t)(lds_ptr_t)lds;
    constexpr int ABYTES = MI * 2048, STAGEB = ABYTES + 8192;
    const unsigned sA = lbase + wid * (MI * 512), sB = lbase + ABYTES + wid * 2048;
    const int roff = (fq ^ ((-(fr >> 2)) & 3)) << 4;
    const char* ardb = lds + (wr * (MI * 16) + fr) * 64 + roff;
    const char* brdb = lds + ABYTES + (wc * 64 + fr) * 64 + roff;
    const int nk = K >> 5;
#define RING_STAGE(st, k0)                                                                                                   \
    {                                                                                                                        \
        const unsigned so_ = (unsigned)(st) * (unsigned)STAGEB;                                                                        \
        _Pragma("unroll") for (int i = 0; i < MI / 2; ++i) glds16((const void*)(ag + (size_t)(i * 16) * lda + (k0)), sA + so_ + i * 1024); \
        _Pragma("unroll") for (int i = 0; i < 2; ++i) glds16((const void*)(bg + (size_t)(i * 16) * ldb + (k0)), sB + so_ + i * 1024); \
    }
    if (!prefetched) {
        __syncthreads();
        RING_STAGE(0, 0);
        RING_STAGE(1, 32);
    }
    int cur = 0;
    for (int kt = 0; kt < nk; ++kt) {
        if (kt + 1 < nk && !(prefetched && kt == 0)) { if (MI == 8) asm volatile("s_waitcnt vmcnt(6)\n\ts_barrier" ::: "memory"); else if (MI == 4) asm volatile("s_waitcnt vmcnt(4)\n\ts_barrier" ::: "memory"); else asm volatile("s_waitcnt vmcnt(3)\n\ts_barrier" ::: "memory"); }
        else asm volatile("s_waitcnt vmcnt(0)\n\ts_barrier" ::: "memory");
        if (kt + 2 < nk) { const int nx = (cur == 0) ? 2 : cur - 1; RING_STAGE(nx, (kt + 2) * 32); }
        const int so = cur * STAGEB;
        bf16x8 bf[4], af[MI];
#pragma unroll
        for (int j = 0; j < 4; ++j) bf[j] = *(const bf16x8*)(brdb + so + j * 1024);
#pragma unroll
        for (int i = 0; i < MI; ++i) af[i] = *(const bf16x8*)(ardb + so + i * 1024);
        if (blockIdx.x & 256) __builtin_amdgcn_s_setprio(3); else __builtin_amdgcn_s_setprio(1);
#pragma unroll
        for (int i = 0; i < MI; ++i) {
#pragma unroll
            for (int j = 0; j < 4; ++j) {
                if (SWAP) acc[i][j] = mfma16(bf[j], af[i], acc[i][j]);
                else acc[i][j] = mfma16(af[i], bf[j], acc[i][j]);
            }
        }
        __builtin_amdgcn_s_setprio(0);
        cur = (cur == 2) ? 0 : cur + 1;
    }
    if (hasNext) {
        __syncthreads();
        ag = A + (size_t)(nm0 + wid * (MI * 8) + srow) * lda + sc;
        bg = Bt + (size_t)(nn0 + wid * 32 + srow) * ldb + sc;
        RING_STAGE(0, 0);
        RING_STAGE(1, 32);
    }
#undef RING_STAGE
    if (SWAP) {
#pragma unroll
        for (int i2 = 0; i2 < MI / 2; ++i2) {
            f32x4 pa[2][4], pg[2][4];
#pragma unroll
            for (int ii = 0; ii < 2; ++ii)
#pragma unroll
                for (int j = 0; j < 4; ++j) epi.pre(m0 + wr * (MI * 16) + (i2 * 2 + ii) * 16 + fr, n0 + wc * 64 + j * 16 + fq * 4, pa[ii][j], pg[ii][j]);
            __builtin_amdgcn_sched_barrier(0);
#pragma unroll
            for (int ii = 0; ii < 2; ++ii)
#pragma unroll
                for (int j = 0; j < 4; ++j) epi.fin(m0 + wr * (MI * 16) + (i2 * 2 + ii) * 16 + fr, n0 + wc * 64 + j * 16 + fq * 4, acc[i2 * 2 + ii][j], pa[ii][j], pg[ii][j]);
        }
    } else {
#pragma unroll
        for (int i = 0; i < MI; ++i)
#pragma unroll
            for (int j = 0; j < 4; ++j) epi.vert(m0 + wr * (MI * 16) + i * 16 + fq * 4, n0 + wc * 64 + j * 16 + fr, acc[i][j]);
    }
}

struct EpiIn {
    bf16_t *P, *VTA, *VTC, *FT; float* G;
    __device__ __forceinline__ void pre(int, int, f32x4&, f32x4&) const {}
    __device__ __forceinline__ void fin(int m, int n, f32x4 v, f32x4, f32x4) const { horiz(m, n, v); }
    __device__ __forceinline__ void horiz(int m, int n, f32x4 v) const {
        if (n < PW) {
            u32x2 w; w.x = pack2(v[0], v[1]); w.y = pack2(v[2], v[3]);
            *(u32x2*)(P + (size_t)m * PW + n) = w;
        } else if (n >= 2816 && n < 2832) {
            *(f32x4*)(G + (size_t)m * 16 + (n - 2816)) = v;
        }
    }
    __device__ __forceinline__ void vert(int m, int n, f32x4 v) const {
        const int which = (n - 1792) >> 8, ch = (n - 1792) & 255;
        SeqInfo s = seqinfo(m);
        u32x2 w; w.x = pack2(v[0], v[1]); w.y = pack2(v[2], v[3]);
        bf16_t* dst;
        if (which == 0) dst = VTA + s.base + (size_t)ch * s.T + s.t;
        else if (which == 1) dst = VTC + s.base + (size_t)ch * s.T + s.t;
        else if (which == 2) dst = FT + 2 * s.base + (size_t)ch * 2 * s.T + s.t;
        else dst = FT + 2 * s.base + (size_t)ch * 2 * s.T + s.T + s.t;
        *(u32x2*)dst = w;
    }
};
struct EpiRes {
    const float *__restrict__ srcLat, *__restrict__ srcCtx; float *__restrict__ dstLat, *__restrict__ dstCtx; const float* __restrict__ mod; int gidx;
    __device__ __forceinline__ void horiz(int m, int n, f32x4 v) const {
        const int b = m < NLAT ? (m >> 11) : 16;
        const f32x4 g = *(const f32x4*)(mod + (size_t)b * 6144 + gidx * 1024 + n);
        const float* __restrict__ s = m < NLAT ? srcLat + (size_t)m * 1024 + n : srcCtx + (size_t)(m - NLAT) * 1024 + n;
        float* __restrict__ d = m < NLAT ? dstLat + (size_t)m * 1024 + n : dstCtx + (size_t)(m - NLAT) * 1024 + n;
        const f32x4 xv = *(const f32x4*)s;
        *(f32x4*)d = xv + g * v;
    }
    __device__ __forceinline__ void pre(int m, int n, f32x4& a, f32x4& g) const {
        const int b = m < NLAT ? (m >> 11) : 16;
        g = *(const f32x4*)(mod + (size_t)b * 6144 + gidx * 1024 + n);
        a = *(const f32x4*)(m < NLAT ? srcLat + (size_t)m * 1024 + n : srcCtx + (size_t)(m - NLAT) * 1024 + n);
    }
    __device__ __forceinline__ void fin(int m, int n, f32x4 v, f32x4 a, f32x4 g) const {
        float* d = m < NLAT ? dstLat + (size_t)m * 1024 + n : dstCtx + (size_t)(m - NLAT) * 1024 + n;
        *(f32x4*)d = a + g * v;
    }
    __device__ __forceinline__ void vert(int, int, f32x4) const {}
};
struct EpiPart {
    float* __restrict__ part; const float* __restrict__ mod; int gidx;
    __device__ __forceinline__ void pre(int, int n, f32x4&, f32x4& g) const { g = *(const f32x4*)(mod + (size_t)16 * 6144 + gidx * 1024 + n); }
    __device__ __forceinline__ void fin(int m, int n, f32x4 v, f32x4, f32x4 g) const { *(f32x4*)(part + (size_t)(m - NLAT) * 1024 + n) = g * v; }
    __device__ __forceinline__ void horiz(int, int, f32x4) const {}
    __device__ __forceinline__ void vert(int, int, f32x4) const {}
};
struct EpiFF1 {
    bf16_t* HID;
    __device__ __forceinline__ void pre(int, int, f32x4&, f32x4&) const {}
    __device__ __forceinline__ void fin(int m, int n, f32x4 v, f32x4, f32x4) const { horiz(m, n, v); }
    __device__ __forceinline__ void horiz(int m, int n, f32x4 v) const {
        float a = fmaxf(v[0], 0.f), b = fmaxf(v[1], 0.f), c = fmaxf(v[2], 0.f), d = fmaxf(v[3], 0.f);
        u32x2 w; w.x = pack2(a * a, b * b); w.y = pack2(c * c, d * d);
        *(u32x2*)(HID + (size_t)m * DFF + n) = w;
    }
    __device__ __forceinline__ void vert(int, int, f32x4) const {}
};
struct EpiDFT {
    bf16_t* MIX; int tok0; float scale;
    __device__ __forceinline__ void horiz(int m, int n, f32x4 v) const {
        u32x2 w; w.x = pack2(v[0] * scale, v[1] * scale); w.y = pack2(v[2] * scale, v[3] * scale);
        *(u32x2*)(MIX + (size_t)(tok0 + m) * 1024 + 768 + n) = w;
    }
    __device__ __forceinline__ void vert(int, int, f32x4) const {}
};

__device__ __forceinline__ void tconv_tile(const float* __restrict__ src, int ld_src, int nvalid, bf16_t* __restrict__ dst, int ld_dst,
                           int k0, int ns0, int nd0, float* t) {
    const int tid = get_tid();
    __syncthreads();
    {
        const int n = tid & 63;
        const bool ok = (ns0 + n < nvalid);
        const int nc = ok ? (ns0 + n) : 0;
        float vv[16];
#pragma unroll
        for (int i = 0; i < 16; ++i) vv[i] = src[(size_t)(k0 + i * 4 + (tid >> 6)) * ld_src + nc];
#pragma unroll
        for (int i = 0; i < 16; ++i) t[(i * 4 + (tid >> 6)) * 65 + n] = ok ? vv[i] : 0.f;
    }
    __syncthreads();
#pragma unroll 4
    for (int i = 0; i < 16; ++i) {
        int n = i * 4 + (tid >> 6), k = tid & 63;
        dst[(size_t)(nd0 + n) * ld_dst + k0 + k] = f2bf(t[k * 65 + n]);
    }
}
__device__ __forceinline__ void fold_dft_tile(const float* __restrict__ w_in_l, bf16_t* __restrict__ WinT_l, int kb, int g, float* t) {
    const int tid = get_tid();
    float* cs = t + 64 * 65;
    __syncthreads();
    if (tid < 64) { cs[tid] = cospif((float)tid / 32.f); cs[64 + tid] = sinpif((float)tid / 32.f); }
    for (int i = 0; i < 16; ++i) {
        int k = i * 4 + (tid >> 6), c = tid & 63;
        t[k * 65 + c] = w_in_l[(size_t)(kb * 64 + k) * DIN + 2304 + g * 64 + c];
    }
    __syncthreads();
    const int k = tid & 63, cg0 = (tid >> 6) * 16;
    for (int cc = 0; cc < 16; ++cc) {
        const int cp = cg0 + cc;
        float sc = 0.f, ss = 0.f;
        for (int c = 0; c < 64; ++c) {
            float v = t[k * 65 + c];
            int idx = (c * cp) & 63;
            sc += v * cs[idx]; ss += v * cs[64 + idx];
        }
        WinT_l[(size_t)(2304 + g * 64 + cp) * 1024 + kb * 64 + k] = f2bf(sc);
        WinT_l[(size_t)(2560 + g * 64 + cp) * 1024 + kb * 64 + k] = f2bf(ss);
    }
}
__device__ __forceinline__ void mod_task(const Params& p, int l, int cb, float* red) {
    const int tid = get_tid(), cl = tid & 63, ks = tid >> 6, col = cb * 64 + cl;
    float acc[17];
#pragma unroll
    for (int r = 0; r < 17; ++r) acc[r] = 0.f;
    const float* W = p.w_ada + (size_t)l * 1024 * 6144;
    float* sl = red + 4352 + ks * 1088;
    for (int kc = 0; kc < 4; ++kc) {
        const int kb = ks * 256 + kc * 64;
        __syncthreads();
#pragma unroll
        for (int r = 0; r < 17; ++r) {
            const float cv = (r < 16) ? p.c[r * 1024 + kb + cl] : p.c_ctx[kb + cl];
            sl[r * 64 + cl] = cv * __builtin_amdgcn_rcpf(1.f + __expf(-cv));
        }
        __syncthreads();
#pragma unroll 1
        for (int k32 = 0; k32 < 64; k32 += 32) {
            float wv_[32];
#pragma unroll
            for (int kk = 0; kk < 32; ++kk) wv_[kk] = W[(size_t)(kb + k32 + kk) * 6144 + col];
#pragma unroll
            for (int kk = 0; kk < 32; ++kk)
#pragma unroll
                for (int r = 0; r < 17; ++r) acc[r] += sl[r * 64 + k32 + kk] * wv_[kk];
        }
    }
    __syncthreads();
#pragma unroll
    for (int r = 0; r < 17; ++r) red[(ks * 17 + r) * 64 + cl] = acc[r];
    __syncthreads();
    float* modall = (float*)(p.ws + OFF_MOD);
    for (int idx = tid; idx < 17 * 64; idx += NTHREADS) {
        int r = idx >> 6, c = idx & 63;
        float s = red[(0 * 17 + r) * 64 + c] + red[(1 * 17 + r) * 64 + c] + red[(2 * 17 + r) * 64 + c] + red[(3 * 17 + r) * 64 + c];
        modall[(size_t)(l * 17 + r) * 6144 + cb * 64 + c] = s + p.b_ada[l * 6144 + cb * 64 + c];
    }
}

__device__ __forceinline__ void prologue_phase(const Params& p, char* lds) {
    float* t = (float*)lds;
    bf16_t* WinT = (bf16_t*)(p.ws + OFF_WIN);
    bf16_t* WoutT = (bf16_t*)(p.ws + OFF_WOUT);
    bf16_t* W1T = (bf16_t*)(p.ws + OFF_W1);
    bf16_t* W2T = (bf16_t*)(p.ws + OFF_W2);
    bf16_t* Wsb = (bf16_t*)(p.ws + OFF_WSP);
    bf16_t* TabL = (bf16_t*)(p.ws + OFF_TABL);
    bf16_t* TabC = (bf16_t*)(p.ws + OFF_TABC);
    const int tid = get_tid();
    constexpr int N_WIN = 2 * 38 * 16;
    constexpr int N_WOUT = 2 * 16 * 12;
    constexpr int N_W1 = 2 * 64 * 16;
    constexpr int N_W2 = 2 * 16 * 64;
    constexpr int N_FOLD = 2 * 16 * 4;
    constexpr int N_WFO = 2 * 32 * 4;
    constexpr int N_WSP = 128;
    constexpr int N_TABL = 1024;
    constexpr int N_TABC = 128;
    constexpr int N_MOD = 2 * 96;
    constexpr int B1 = N_WIN, B2 = B1 + N_WOUT, B3 = B2 + N_W1, B4 = B3 + N_W2, B5 = B4 + N_FOLD, B6 = B5 + N_WFO,
                  B7 = B6 + N_WSP, B8 = B7 + N_TABL, B9 = B8 + N_TABC, B10 = B9 + N_MOD;
    for (int task = blockIdx.x; task < B10; task += gridDim.x) {
        if (task < B1) {
            int l = task / (38 * 16), r = task % (38 * 16), nb = r / 16, kb = r % 16;
            int nd0 = nb * 64, ns0 = 0, nvalid = DIN;
            if (nb < 8) ns0 = nd0;
            else if (nb < 16) ns0 = 768 + (nd0 - 512);
            else if (nb < 24) ns0 = 1280 + (nd0 - 1024);
            else if (nb < 28) ns0 = 2048 + (nd0 - 1536);
            else if (nb < 32) ns0 = 512 + (nd0 - 1792);
            else if (nb < 36) ns0 = 1792 + (nd0 - 2048);
            else if (nb == 36) { nd0 = 2816; ns0 = 2560; }
            else { nd0 = 2880; ns0 = 0; nvalid = 0; }
            tconv_tile(p.w_in + (size_t)l * 1024 * DIN, DIN, nvalid, WinT + (size_t)l * NPAD * 1024, 1024, kb * 64, ns0, nd0, t);
        } else if (task < B2) {
            int q = task - B1, l = q / 192, r = q % 192, nb = r / 12, kb = r % 12;
            tconv_tile(p.w_out + (size_t)l * 1024 * 1024, 1024, 1024, WoutT + (size_t)l * 1024 * 1024, 1024, kb * 64, nb * 64, nb * 64, t);
        } else if (task < B3) {
            int q = task - B2, l = q / 1024, r = q % 1024, nb = r / 16, kb = r % 16;
            tconv_tile(p.w_ff1 + (size_t)l * 1024 * 4096, 4096, 4096, W1T + (size_t)l * 4096 * 1024, 1024, kb * 64, nb * 64, nb * 64, t);
        } else if (task < B4) {
            int q = task - B3, l = q / 1024, r = q % 1024, nb = r / 64, kb = r % 64;
            tconv_tile(p.w_ff2 + (size_t)l * 4096 * 1024, 1024, 1024, W2T + (size_t)l * 1024 * 4096, 4096, kb * 64, nb * 64, nb * 64, t);
        } else if (task < B5) {
            int q = task - B4, l = q / 64, r = q % 64, kb = r / 4, g = r % 4;
            fold_dft_tile(p.w_in + (size_t)l * 1024 * DIN, WinT + (size_t)l * NPAD * 1024, kb, g, t);
        } else if (task < B6) {
            const int q = task - B5, l = q / 128, r = q % 128, i0 = (r >> 2) * 8, n = (r & 3) * 256 + tid;
            const float* __restrict__ wf = p.w_fnet + (size_t)l * 256 * 256 + (size_t)i0 * 256;
            const float* __restrict__ wo = p.w_out + (size_t)l * 1024 * 1024 + (size_t)768 * 1024 + n;
            float a8[8];
#pragma unroll
            for (int ii = 0; ii < 8; ++ii) a8[ii] = 0.f;
#pragma unroll 1
            for (int j0 = 0; j0 < 256; j0 += 32) {
                float wv_[32];
#pragma unroll
                for (int jj = 0; jj < 32; ++jj) wv_[jj] = wo[(size_t)(j0 + jj) * 1024];
#pragma unroll
                for (int jj = 0; jj < 32; ++jj)
#pragma unroll
                    for (int ii = 0; ii < 8; ++ii) a8[ii] += wf[ii * 256 + j0 + jj] * wv_[jj];
            }
            u32x4 o4;
            o4[0] = pack2(a8[0], a8[1]); o4[1] = pack2(a8[2], a8[3]); o4[2] = pack2(a8[4], a8[5]); o4[3] = pack2(a8[6], a8[7]);
            *(u32x4*)(WoutT + (size_t)l * 1024 * 1024 + (size_t)n * 1024 + 768 + i0) = o4;
        } else if (task < B7) {
            int q = task - B6;
            for (int e = 0; e < 4; ++e) { int idx = q * 1024 + e * 256 + tid; Wsb[idx] = f2bf(p.w_sp[idx]); }
        } else if (task < B8) {
            int tp = task - B7;
            for (int e = 0; e < 16; ++e) {
                int k = e * 256 + tid;
                int tt = k & 2047;
                int idx = (tt * tp) & 2047;
                float ang = (float)idx / 1024.f;
                float v = (k < 2048) ? cospif(ang) : -sinpif(ang);
                TabL[(size_t)tp * 4096 + k] = f2bf(v);
            }
        } else if (task < B9) {
            int q = task - B8;
            for (int e = 0; e < 4; ++e) {
                int id = q * 1024 + e * 256 + tid;
                int tp = id >> 9, k = id & 511, tt = k & 255;
                int idx = (tt * tp) & 255;
                float ang = (float)idx / 128.f;
                float v = (k < 256) ? cospif(ang) : -sinpif(ang);
                TabC[id] = f2bf(v);
            }
        } else {
            int q = task - B9, l = q / 96, cb = q % 96;
            mod_task(p, l, cb, t);
        }
    }
}

__device__ __forceinline__ void norm_phase(const Params& p, int l, const float* srcLat, const float* srcCtx, const float* g, int shiftIdx, int scaleIdx, int M, const float* ctxExtra = nullptr) {
    const int tid = get_tid(), lane = tid & 63;
    const int wave = blockIdx.x * 4 + (tid >> 6), nw = gridDim.x * 4;
    const float* modall = (const float*)(p.ws + OFF_MOD);
    bf16_t* H = (bf16_t*)(p.ws + OFF_HM);
    for (int row0 = wave; row0 < M; row0 += 2 * nw) {
        const bool has1 = (row0 + nw) < M;
        int rows[2]; rows[0] = row0; rows[1] = has1 ? row0 + nw : row0;
        f32x4 v[2][4], gv[4], scv[2][4], shv[2][4];
#pragma unroll
        for (int rI = 0; rI < 2; ++rI) {
            const int row = rows[rI];
            const float* xr = row < NLAT ? srcLat + (size_t)row * 1024 : srcCtx + (size_t)(row - NLAT) * 1024;
            const int b = row < NLAT ? (row >> 11) : 16;
            const float* mod = modall + (size_t)(l * 17 + b) * 6144;
#pragma unroll
            for (int i = 0; i < 4; ++i) {
                const int col = i * 256 + lane * 4;
                v[rI][i] = *(const f32x4*)(xr + col);
                if (ctxExtra != nullptr && row >= NLAT) v[rI][i] += *(const f32x4*)(ctxExtra + (size_t)(row - NLAT) * 1024 + col);
                scv[rI][i] = *(const f32x4*)(mod + scaleIdx * 1024 + col);
                shv[rI][i] = *(const f32x4*)(mod + shiftIdx * 1024 + col);
            }
        }
#pragma unroll
        for (int i = 0; i < 4; ++i) gv[i] = *(const f32x4*)(g + i * 256 + lane * 4);
        __builtin_amdgcn_sched_barrier(0);
#pragma unroll
        for (int rI = 0; rI < 2; ++rI) {
            float ss = 0.f;
#pragma unroll
            for (int i = 0; i < 4; ++i) ss += v[rI][i][0] * v[rI][i][0] + v[rI][i][1] * v[rI][i][1] + v[rI][i][2] * v[rI][i][2] + v[rI][i][3] * v[rI][i][3];
#pragma unroll
            for (int o = 32; o >= 1; o >>= 1) ss += shx(ss, o, lane);
            const float rstd = rsqrtf(ss * (1.f / 1024.f) + 1e-6f);
            if (rI == 0 || has1) {
#pragma unroll
                for (int i = 0; i < 4; ++i) {
                    const int col = i * 256 + lane * 4;
                    f32x4 y = v[rI][i] * rstd * gv[i] * (scv[rI][i] + 1.f) + shv[rI][i];
                    u32x2 w; w.x = pack2(y[0], y[1]); w.y = pack2(y[2], y[3]);
                    *(u32x2*)(H + (size_t)rows[rI] * 1024 + col) = w;
                }
            }
        }
    }
}
__device__ __forceinline__ void final_norm_phase(const Params& p) {
    const int tid = get_tid(), lane = tid & 63;
    const int wave = blockIdx.x * 4 + (tid >> 6), nw = gridDim.x * 4;
    for (int row = wave; row < NLAT; row += nw) {
        float* xr = p.out + (size_t)row * 1024;
        f32x4 v[4], gfv[4];
        float ss = 0.f;
#pragma unroll
        for (int i = 0; i < 4; ++i) { v[i] = *(const f32x4*)(xr + i * 256 + lane * 4); gfv[i] = *(const f32x4*)(p.g_final + i * 256 + lane * 4); }
        __builtin_amdgcn_sched_barrier(0);
#pragma unroll
        for (int i = 0; i < 4; ++i) ss += v[i][0] * v[i][0] + v[i][1] * v[i][1] + v[i][2] * v[i][2] + v[i][3] * v[i][3];
#pragma unroll
        for (int o = 32; o >= 1; o >>= 1) ss += shx(ss, o, lane);
        const float rstd = rsqrtf(ss * (1.f / 1024.f) + 1e-6f);
#pragma unroll
        for (int i = 0; i < 4; ++i) {
            const int col = i * 256 + lane * 4;
            const f32x4 gg = gfv[i];
            *(f32x4*)(xr + col) = v[i] * rstd * gg;
        }
    }
}

__device__ __forceinline__ void attn_chunk(f32x4 (&st)[16], float& m_run, float& sum, f32x4 (&o)[4], const bf16_t* vbase,
                                           int pairStride, size_t ndStride, int fq, int lane) {
    bf16x8 vb0[4][4];
#pragma unroll
    for (int i = 0; i < 4; ++i)
#pragma unroll
        for (int nd = 0; nd < 4; ++nd) {
            const bf16_t* vp = vbase + nd * ndStride + i * pairStride;
            vb0[i][nd] = cat4(*(const bf16x4*)vp, *(const bf16x4*)(vp + 16));
        }
    __builtin_amdgcn_sched_barrier(0);
    float mx = m_run;
#pragma unroll
    for (int i = 0; i < 16; ++i) mx = fmaxf(mx, fmaxf(fmaxf(st[i][0], st[i][1]), fmaxf(st[i][2], st[i][3])));
    mx = fmaxf(mx, shx(mx, 16, lane));
    mx = fmaxf(mx, shx(mx, 32, lane));
    const float scale = __expf(m_run - mx);
    float cs = 0.f;
#pragma unroll
    for (int i = 0; i < 16; ++i)
#pragma unroll
        for (int j = 0; j < 4; ++j) { float e = __expf(st[i][j] - mx); st[i][j] = e; cs += e; }
    cs += shx(cs, 16, lane);
    cs += shx(cs, 32, lane);
    sum = sum * scale + cs;
    m_run = mx;
#pragma unroll
    for (int j = 0; j < 4; ++j) {
        const float sq = shi(scale, fq * 4 + j);
#pragma unroll
        for (int nd = 0; nd < 4; ++nd) o[nd][j] *= sq;
    }
    bf16x8 vb1[4][4];
#pragma unroll
    for (int i = 0; i < 4; ++i)
#pragma unroll
        for (int nd = 0; nd < 4; ++nd) {
            const bf16_t* vp = vbase + nd * ndStride + (i + 4) * pairStride;
            vb1[i][nd] = cat4(*(const bf16x4*)vp, *(const bf16x4*)(vp + 16));
        }
    __builtin_amdgcn_sched_barrier(0);
#pragma unroll
    for (int i = 0; i < 4; ++i) {
        const bf16x8 pa = packw(st[2 * i], st[2 * i + 1]);
#pragma unroll
        for (int nd = 0; nd < 4; ++nd) o[nd] = mfma16(pa, vb0[i][nd], o[nd]);
    }
#pragma unroll
    for (int i = 0; i < 4; ++i) {
        const bf16x8 pa = packw(st[2 * i + 8], st[2 * i + 9]);
#pragma unroll
        for (int nd = 0; nd < 4; ++nd) o[nd] = mfma16(pa, vb1[i][nd], o[nd]);
    }
}

template <bool CTXQ>
__device__ __forceinline__ void attn_unit(const Params& p, int l, int u, char* lds) {
    const bf16_t* __restrict__ P = (const bf16_t*)(p.ws + OFF_P);
    const bf16_t* VTA = (const bf16_t*)(p.ws + OFF_VTA);
    bf16_t* __restrict__ MIX = (bf16_t*)(p.ws + OFF_HM);
    float* rp = (float*)lds;
    const int tid = get_tid(), lane = tid & 63, w = tid >> 6, fr = lane & 15, fq = lane >> 4;
    int b, h, r = 0, qb = 0;
    if (CTXQ) { b = u >> 4; h = (u >> 2) & 3; qb = u & 3; }
    else { b = u >> 7; h = (u >> 5) & 3; r = u & 31; }
    if (!CTXQ) {
        __syncthreads();
        for (int i = tid; i < 465; i += NTHREADS) rp[i] = p.rpb[(size_t)(l * 4 + h) * 465 + i];
        __syncthreads();
    }
    const int tq0 = CTXQ ? NLAT + b * 256 + qb * 64 + w * 16 : b * 2048 + r * 64 + w * 16;
    const bf16_t* qp = P + (size_t)(tq0 + fr) * PW + h * 64 + fq * 8;
    const bf16x8 bq0 = *(const bf16x8*)qp, bq1 = *(const bf16x8*)(qp + 32);
    float m_run = -3e38f, sum = 0.f;
    f32x4 o[4];
#pragma unroll
    for (int nd = 0; nd < 4; ++nd) o[nd] = (f32x4){0.f, 0.f, 0.f, 0.f};
    f32x4 st[16];
    if (!CTXQ) {
        const int rs = min(max(r - 4, 0), 24), ks0 = min(max(w * 16 - 8, 0), 32);
        const int c = w * 16 + fr, qs = min(max(c - 8, 0), 48);
#pragma unroll
        for (int bt = 0; bt < 2; ++bt) {
            bf16x8 ka[8][2];
#pragma unroll
            for (int t8 = 0; t8 < 8; ++t8) {
                const int rr = bt * 4 + (t8 >> 1), ct = t8 & 1;
                const int tokk = b * 2048 + (rs + rr) * 64 + ks0 + ct * 16 + fr;
                const bf16_t* kp = P + (size_t)tokk * PW + 256 + h * 64 + fq * 8;
                ka[t8][0] = *(const bf16x8*)kp; ka[t8][1] = *(const bf16x8*)(kp + 32);
            }
            __builtin_amdgcn_sched_barrier(0);
#pragma unroll
            for (int t8 = 0; t8 < 8; ++t8) {
                const int rr = bt * 4 + (t8 >> 1), ct = t8 & 1;
                f32x4 acc = (f32x4){0.f, 0.f, 0.f, 0.f};
                acc = mfma16(ka[t8][0], bq0, acc);
                acc = mfma16(ka[t8][1], bq1, acc);
#pragma unroll
                for (int j = 0; j < 4; ++j) {
                    const int kc = ks0 + ct * 16 + fq * 4 + j;
                    const bool valid = (kc >= qs) && (kc < qs + 16);
                    const int bi = valid ? (rs + rr - r + 7) * 31 + (kc - c + 15) : 0;
                    const float bias = rp[bi];
                    st[rr * 2 + ct][j] = valid ? acc[j] * 0.125f + bias : -1e30f;
                }
            }
        }
        const bf16_t* vbase = VTA + (size_t)b * 256 * 2048 + (size_t)(h * 64 + fr) * 2048 + rs * 64 + ks0 + 4 * fq;
        attn_chunk(st, m_run, sum, o, vbase, 64, (size_t)16 * 2048, fq, lane);
    }
#pragma unroll
    for (int bt = 0; bt < 2; ++bt) {
        bf16x8 ka[8][2];
#pragma unroll
        for (int t8 = 0; t8 < 8; ++t8) {
            const int tokk = NLAT + b * 256 + (bt * 8 + t8) * 16 + fr;
            const bf16_t* kp = P + (size_t)tokk * PW + 256 + h * 64 + fq * 8;
            ka[t8][0] = *(const bf16x8*)kp; ka[t8][1] = *(const bf16x8*)(kp + 32);
        }
        __builtin_amdgcn_sched_barrier(0);
#pragma unroll
        for (int t8 = 0; t8 < 8; ++t8) {
            f32x4 acc = (f32x4){0.f, 0.f, 0.f, 0.f};
            acc = mfma16(ka[t8][0], bq0, acc);
            acc = mfma16(ka[t8][1], bq1, acc);
            st[bt * 8 + t8] = acc * 0.125f;
        }
    }
    {
        const bf16_t* vbase = VTA + (size_t)NLAT * 256 + (size_t)b * 256 * 256 + (size_t)(h * 64 + fr) * 256 + 4 * fq;
        attn_chunk(st, m_run, sum, o, vbase, 32, (size_t)16 * 256, fq, lane);
    }
#pragma unroll
    for (int j = 0; j < 4; ++j) {
        const int q = fq * 4 + j;
        const float inv = __builtin_amdgcn_rcpf(shi(sum, q));
#pragma unroll
        for (int nd = 0; nd < 4; ++nd) MIX[(size_t)(tq0 + q) * 1024 + h * 64 + nd * 16 + fr] = f2bf(o[nd][j] * inv);
    }
}

__device__ __forceinline__ void attn_softmax(f32x4 (&st)[16], float& m_run, float& sum, f32x4 (&o)[4], int fq, int lane) {
    float mx = m_run;
#pragma unroll
    for (int i = 0; i < 16; ++i) mx = fmaxf(mx, fmaxf(fmaxf(st[i][0], st[i][1]), fmaxf(st[i][2], st[i][3])));
    mx = fmaxf(mx, shx(mx, 16, lane));
    mx = fmaxf(mx, shx(mx, 32, lane));
    const float scale = __expf(m_run - mx);
    float cs = 0.f;
#pragma unroll
    for (int i = 0; i < 16; ++i)
#pragma unroll
        for (int j = 0; j < 4; ++j) { float e = __expf(st[i][j] - mx); st[i][j] = e; cs += e; }
    cs += shx(cs, 16, lane);
    cs += shx(cs, 32, lane);
    sum = sum * scale + cs;
    m_run = mx;
#pragma unroll
    for (int j = 0; j < 4; ++j) {
        const float sq = shi(scale, fq * 4 + j);
#pragma unroll
        for (int nd = 0; nd < 4; ++nd) o[nd][j] *= sq;
    }
}
__device__ __forceinline__ void attn_pv(const f32x4 (&st)[16], f32x4 (&o)[4], const char* vt, int rowB, int tl0, int pairTok, int fr, int fq) {
#pragma unroll
    for (int i = 0; i < 8; ++i) {
        const bf16x8 pa = packw(st[2 * i], st[2 * i + 1]);
        const int tl = tl0 + i * pairTok + 4 * fq, tl2 = tl + 16;
#pragma unroll
        for (int nd = 0; nd < 4; ++nd) {
            const int d = nd * 16 + fr;
            const char* row = vt + d * rowB;
            const bf16x4 v0 = *(const bf16x4*)(row + (((tl >> 3) ^ (d & 15)) << 4) + (tl & 7) * 2);
            const bf16x4 v1 = *(const bf16x4*)(row + (((tl2 >> 3) ^ (d & 15)) << 4) + (tl2 & 7) * 2);
            o[nd] = mfma16(pa, cat4(v0, v1), o[nd]);
        }
    }
}
template <bool CTXQ>
__device__ __forceinline__ void attn_unit2(const Params& p, int l, int u, char* lds) {
    const bf16_t* __restrict__ P = (const bf16_t*)(p.ws + OFF_P);
    const bf16_t* __restrict__ VTA = (const bf16_t*)(p.ws + OFF_VTA);
    bf16_t* __restrict__ MIX = (bf16_t*)(p.ws + OFF_HM);
    float* rp = (float*)lds;
    char* sg = lds + 2048;
    const unsigned lb = (unsigned)(size_t)(lds_ptr_t)lds + 2048u;
    const int tid = get_tid(), lane = tid & 63, w = __builtin_amdgcn_readfirstlane(tid >> 6), fr = lane & 15, fq = lane >> 4;
    int b, h, r = 0, qb = 0;
    if (CTXQ) { b = u >> 4; h = (u >> 2) & 3; qb = u & 3; }
    else { b = u >> 7; h = (u >> 5) & 3; r = u & 31; }
    __syncthreads();
    if (!CTXQ) { for (int i = tid; i < 465; i += NTHREADS) rp[i] = p.rpb[(size_t)(l * 4 + h) * 465 + i]; }
    const int tq0 = CTXQ ? NLAT + b * 256 + qb * 64 + w * 16 : b * 2048 + r * 64 + w * 16;
    const bf16_t* qp = P + (size_t)(tq0 + fr) * PW + h * 64 + fq * 8;
    const bf16x8 bq0 = *(const bf16x8*)qp, bq1 = *(const bf16x8*)(qp + 32);
    float m_run = -3e38f, sum = 0.f;
    f32x4 o[4];
#pragma unroll
    for (int nd = 0; nd < 4; ++nd) o[nd] = (f32x4){0.f, 0.f, 0.f, 0.f};
    f32x4 st[16];
    const int ksw = lane >> 4, kch = lane & 7, krow = lane >> 3;
    if (!CTXQ) {
        const int rs = min(max(r - 4, 0), 24), ks0 = min(max(w * 16 - 8, 0), 32);
        const int c = w * 16 + fr, qs = min(max(c - 8, 0), 48);
        const int tokb = b * 2048 + rs * 64;
#pragma unroll
        for (int i = 0; i < 16; ++i) {
            const int pc = w * 16 + i;
            const int sc = kch ^ (((pc & 1) * 4 + ksw) & 7);
            glds16((const void*)(P + (size_t)(tokb + pc * 8 + krow) * PW + 256 + h * 64 + sc * 8), lb + pc * 1024);
        }
        asm volatile("s_waitcnt vmcnt(0)" ::: "memory");
        __syncthreads();
#pragma unroll
        for (int rr = 0; rr < 8; ++rr)
#pragma unroll
            for (int ct = 0; ct < 2; ++ct) {
                const int tokidx = rr * 64 + ks0 + ct * 16 + fr, sw = (tokidx >> 1) & 7;
                const bf16x8 ka0 = *(const bf16x8*)(sg + tokidx * 128 + ((fq ^ sw) << 4));
                const bf16x8 ka1 = *(const bf16x8*)(sg + tokidx * 128 + (((4 + fq) ^ sw) << 4));
                f32x4 acc = (f32x4){0.f, 0.f, 0.f, 0.f};
                acc = mfma16(ka0, bq0, acc);
                acc = mfma16(ka1, bq1, acc);
#pragma unroll
                for (int j = 0; j < 4; ++j) {
                    const int kc = ks0 + ct * 16 + fq * 4 + j;
                    const bool valid = (kc >= qs) && (kc < qs + 16);
                    const int bi = valid ? (rs + rr - r + 7) * 31 + (kc - c + 15) : 0;
                    const float bias = rp[bi];
                    st[rr * 2 + ct][j] = valid ? acc[j] * 0.125f + bias : -1e30f;
                }
            }
        __syncthreads();
#pragma unroll
        for (int i = 0; i < 16; ++i) {
            const int d = w * 16 + i;
            glds16((const void*)(VTA + (size_t)b * 256 * 2048 + (size_t)(h * 64 + d) * 2048 + rs * 64 + ((lane ^ (d & 15)) << 3)), lb + d * 1024);
        }
        attn_softmax(st, m_run, sum, o, fq, lane);
        asm volatile("s_waitcnt vmcnt(0)" ::: "memory");
        __syncthreads();
        attn_pv(st, o, sg, 1024, ks0, 64, fr, fq);
        __syncthreads();
    }
#pragma unroll
    for (int i = 0; i < 8; ++i) {
        const int pc = w * 8 + i;
        const int sc = kch ^ (((pc & 1) * 4 + ksw) & 7);
        glds16((const void*)(P + (size_t)(NLAT + b * 256 + pc * 8 + krow) * PW + 256 + h * 64 + sc * 8), lb + pc * 1024);
    }
#pragma unroll
    for (int i = 0; i < 8; ++i) {
        const int jj = w * 8 + i;
        const int d = 2 * jj + (lane >> 5), cp = lane & 31;
        glds16((const void*)(VTA + (size_t)NLAT * 256 + (size_t)b * 256 * 256 + (size_t)(h * 64 + d) * 256 + ((cp ^ (d & 15)) << 3)), lb + 32768 + jj * 1024);
    }
    asm volatile("s_waitcnt vmcnt(0)" ::: "memory");
    __syncthreads();
#pragma unroll
    for (int ct = 0; ct < 16; ++ct) {
        const int tokidx = ct * 16 + fr, sw = (tokidx >> 1) & 7;
        const bf16x8 ka0 = *(const bf16x8*)(sg + tokidx * 128 + ((fq ^ sw) << 4));
        const bf16x8 ka1 = *(const bf16x8*)(sg + tokidx * 128 + (((4 + fq) ^ sw) << 4));
        f32x4 acc = (f32x4){0.f, 0.f, 0.f, 0.f};
        acc = mfma16(ka0, bq0, acc);
        acc = mfma16(ka1, bq1, acc);
        st[ct] = acc * 0.125f;
    }
    attn_softmax(st, m_run, sum, o, fq, lane);
    attn_pv(st, o, sg + 32768, 512, 0, 32, fr, fq);
#pragma unroll
    for (int j = 0; j < 4; ++j) {
        const int q = fq * 4 + j;
        const float inv = __builtin_amdgcn_rcpf(shi(sum, q));
#pragma unroll
        for (int nd = 0; nd < 4; ++nd) MIX[(size_t)(tq0 + q) * 1024 + h * 64 + nd * 16 + fr] = f2bf(o[nd][j] * inv);
    }
}

__device__ __forceinline__ void gmlp_unit(const Params& p, int l, int u, char* lds) {
    const bf16_t* __restrict__ P = (const bf16_t*)(p.ws + OFF_P);
    const bf16_t* Wsb = (const bf16_t*)(p.ws + OFF_WSP);
    bf16_t* __restrict__ MIX = (bf16_t*)(p.ws + OFF_HM);
    float* rs = (float*)lds;
    bf16_t* zT = (bf16_t*)(lds + 512);
    const int tid = get_tid(), lane = tid & 63, w = tid >> 6, fr = lane & 15, fq = lane >> 4;
    int tok0;
    if (u < 256) tok0 = (u >> 4) * 2048 + (u & 15) * 128;
    else { int j = u - 256; tok0 = NLAT + (j >> 1) * 256 + (j & 1) * 128; }
    __syncthreads();
    {
        const int q = tid >> 1, hf = tid & 1;
        const bf16_t* zp = P + (size_t)(tok0 + q) * PW + 768 + hf * 128;
        float ss = 0.f;
#pragma unroll
        for (int i = 0; i < 16; ++i) {
            const bf16x8 v = *(const bf16x8*)(zp + i * 8);
#pragma unroll
            for (int e = 0; e < 8; ++e) { float z = gelu_tanh(bfs2f(v[e])); ss += z * z; }
        }
        ss += shx(ss, 1, lane);
        if (!hf) rs[q] = rsqrtf(ss * (1.f / 256.f) + 1e-6f);
    }
    for (int h = 0; h < 4; ++h) {
        bf16x8 afr[4][2];
        __syncthreads();
        {
            const int q = tid & 127, dh = tid >> 7;
            const bf16_t* zp = P + (size_t)(tok0 + q) * PW + 768 + h * 64 + dh * 32;
            const float r = rs[q];
            bf16x8 zv[4];
#pragma unroll
            for (int i4 = 0; i4 < 4; ++i4) zv[i4] = *(const bf16x8*)(zp + i4 * 8);
#pragma unroll
            for (int ks = 0; ks < 4; ++ks)
#pragma unroll
                for (int i = 0; i < 2; ++i) afr[ks][i] = *(const bf16x8*)(Wsb + (size_t)((l * 4 + h) * 128 + w * 32 + i * 16 + fr) * 128 + ks * 32 + fq * 8);
            __builtin_amdgcn_sched_barrier(0);
#pragma unroll
            for (int i4 = 0; i4 < 4; ++i4) {
                const bf16x8 v = zv[i4];
#pragma unroll
                for (int e = 0; e < 8; ++e) {
                    const int d = dh * 32 + i4 * 8 + e;
                    zT[d * 136 + q] = f2bf(gelu_tanh(bfs2f(v[e])) * r * p.g_gmlp[l * 256 + h * 64 + d]);
                }
            }
        }
        __syncthreads();
        f32x4 acc[2][4];
#pragma unroll
        for (int i = 0; i < 2; ++i)
#pragma unroll
            for (int nd = 0; nd < 4; ++nd) acc[i][nd] = (f32x4){0.f, 0.f, 0.f, 0.f};
#pragma unroll
        for (int ks = 0; ks < 4; ++ks) {
            bf16x8 a[2], bb[4];
#pragma unroll
            for (int i = 0; i < 2; ++i) a[i] = afr[ks][i];
#pragma unroll
            for (int nd = 0; nd < 4; ++nd) bb[nd] = *(const bf16x8*)(zT + (nd * 16 + fr) * 136 + ks * 32 + fq * 8);
#pragma unroll
            for (int i = 0; i < 2; ++i)
#pragma unroll
                for (int nd = 0; nd < 4; ++nd) acc[i][nd] = mfma16(a[i], bb[nd], acc[i][nd]);
        }
#pragma unroll
        for (int i = 0; i < 2; ++i) {
            bf16_t uraw[4][4];
            float bsv[4];
#pragma unroll
            for (int j = 0; j < 4; ++j) {
                const int pi = w * 32 + i * 16 + fq * 4 + j;
                bsv[j] = p.b_sp[(l * 4 + h) * 128 + pi];
#pragma unroll
                for (int nd = 0; nd < 4; ++nd) uraw[j][nd] = P[(size_t)(tok0 + pi) * PW + 512 + h * 64 + nd * 16 + fr];
            }
            __builtin_amdgcn_sched_barrier(0);
#pragma unroll
            for (int j = 0; j < 4; ++j) {
                const int pi = w * 32 + i * 16 + fq * 4 + j;
#pragma unroll
                for (int nd = 0; nd < 4; ++nd) {
                    const int ch = h * 64 + nd * 16 + fr;
                    const float uu = gelu_tanh(bf2f(uraw[j][nd]));
                    MIX[(size_t)(tok0 + pi) * 1024 + 256 + ch] = f2bf(uu * (acc[i][nd][j] + bsv[j]));
                }
            }
        }
    }
}

__device__ __forceinline__ void prep_unit(const Params& p, int l, int u) {
    const bf16_t* __restrict__ P = (const bf16_t*)(p.ws + OFF_P);
    bf16_t* Qc = (bf16_t*)(p.ws + OFF_QC);
    bf16_t* Kc = (bf16_t*)(p.ws + OFF_KC);
    bf16_t* KcT = (bf16_t*)(p.ws + OFF_KCT);
    const int tid = get_tid();
    const int tok0 = u * 8;
    const SeqInfo s = seqinfo(tok0);
    const bool isctx = tok0 >= NLAT;
    const int qk = tid >> 7, h = (tid >> 5) & 3, half = (tid >> 4) & 1, i = tid & 15;
    const int c1 = h * 64 + half * 32 + i, c2 = c1 + 16;
    const bf16_t* Pc = P + 1024 + qk * 256;
    const float* wc = p.w_conv + (size_t)l * 3 * 512 + qk * 256;
    const float w10 = wc[c1], w11 = wc[512 + c1], w12 = wc[1024 + c1];
    const float w20 = wc[c2], w21 = wc[512 + c2], w22 = wc[1024 + c2];
    float x1[10], x2[10];
#pragma unroll
    for (int jj = 0; jj < 10; ++jj) {
        const int tp = s.t - 1 + jj;
        const bool valid = (tp >= 0) && (tp < s.T);
        const int tpc = min(max(tp, 0), s.T - 1);
        const size_t off = (size_t)(tok0 - s.t + tpc) * PW;
        const float l1 = bf2f(Pc[off + c1]), l2 = bf2f(Pc[off + c2]);
        x1[jj] = valid ? l1 : 0.f;
        x2[jj] = valid ? l2 : 0.f;
    }
    const float inv = exp2f(-(float)i * (13.287712379549449f / 16.f));
    bf16_t o1[8], o2[8];
    bf16_t* dn = qk ? Kc : Qc;
#pragma unroll
    for (int t = 0; t < 8; ++t) {
        const float y1 = w10 * x1[t] + w11 * x1[t + 1] + w12 * x1[t + 2];
        const float y2 = w20 * x2[t] + w21 * x2[t + 1] + w22 * x2[t + 2];
        const float s1 = y1 * __builtin_amdgcn_rcpf(1.f + __expf(-y1)), s2 = y2 * __builtin_amdgcn_rcpf(1.f + __expf(-y2));
        float r1 = s1, r2 = s2;
        if (!isctx) {
            const int tp = s.t + t;
            const float pos = half ? (float)(tp & 63) : (float)(tp >> 6);
            float sn, cs;
            sincosf(pos * inv, &sn, &cs);
            r1 = s1 * cs - s2 * sn;
            r2 = s1 * sn + s2 * cs;
        }
        if (qk) { r1 *= 0.125f; r2 *= 0.125f; }
        o1[t] = f2bf(r1); o2[t] = f2bf(r2);
        dn[(size_t)(tok0 + t) * 256 + c1] = o1[t];
        dn[(size_t)(tok0 + t) * 256 + c2] = o2[t];
    }
    if (qk) {
        u32x4 a, bq;
        a.x = o1[0] | ((unsigned)o1[1] << 16); a.y = o1[2] | ((unsigned)o1[3] << 16); a.z = o1[4] | ((unsigned)o1[5] << 16); a.w = o1[6] | ((unsigned)o1[7] << 16);
        bq.x = o2[0] | ((unsigned)o2[1] << 16); bq.y = o2[2] | ((unsigned)o2[3] << 16); bq.z = o2[4] | ((unsigned)o2[5] << 16); bq.w = o2[6] | ((unsigned)o2[7] << 16);
        *(u32x4*)(KcT + s.base + (size_t)c1 * s.T + s.t) = a;
        *(u32x4*)(KcT + s.base + (size_t)c2 * s.T + s.t) = bq;
    }
}

__device__ __forceinline__ void load_gates(const Params& p, int l, int tok0, int h, int dir, float* gi, float* gf, float* bc) {
    const float* G = (const float*)(p.ws + OFF_G);
    const int tid = get_tid();
    __syncthreads();
    if (tid < 128) {
        const float* gr = G + (size_t)(tok0 + tid) * 16 + dir * 8;
        gi[tid] = gr[h] + p.b_gate[l * 16 + dir * 8 + h];
        gf[tid] = logsigmoidf_(gr[4 + h] + p.b_gate[l * 16 + dir * 8 + 4 + h]);
    }
    __syncthreads();
    if (tid < 64) {
        const int lane = get_tid();
        int t0, t1;
        if (!dir) { t0 = 2 * lane; t1 = 2 * lane + 1; } else { t0 = 127 - 2 * lane; t1 = 126 - 2 * lane; }
        const float a = gf[t0], b2 = gf[t1];
        float s = a + b2;
#pragma unroll
        for (int o = 1; o < 64; o <<= 1) { float v = shi(s, lane - o); if (lane >= o) s += v; }
        bc[t1] = s;
        bc[t0] = s - b2;
    }
    __syncthreads();
}

__device__ __forceinline__ void c1_unit(const Params& p, int l, int unit, char* lds) {
    const bf16_t* __restrict__ VTC = (const bf16_t*)(p.ws + OFF_VTC);
    const bf16_t* KcT = (const bf16_t*)(p.ws + OFF_KCT);
    float* Ub = (float*)(p.ws + OFF_UB);
    float* Usc = (float*)(p.ws + OFF_USC);
    const int tid = get_tid(), lane = tid & 63, w = tid >> 6, fr = lane & 15, fq = lane >> 4;
    const int kk = unit % 18, chain = unit / 18, dir = chain & 1, h = (chain >> 1) & 3, b = chain >> 3;
    int isctx, chunk;
    if (kk < 2) { isctx = 1; chunk = dir ? 1 - kk : kk; } else { isctx = 0; chunk = dir ? 17 - kk : kk - 2; }
    const int tok0 = isctx ? NLAT + b * 256 + chunk * 128 : b * 2048 + chunk * 128;
    const SeqInfo s = seqinfo(tok0);
    float* gi = (float*)lds; float* gf = gi + 128; float* bc = gf + 128; float* wv = bc + 128; float* sc = wv + 128;
    bf16x8 kbf[4], vaf[4][4];
#pragma unroll
    for (int ks = 0; ks < 4; ++ks) {
        const int so = ks * 32 + fq * 8;
        kbf[ks] = *(const bf16x8*)(KcT + s.base + (size_t)(h * 64 + 16 * w + fr) * s.T + s.t + so);
#pragma unroll
        for (int mt = 0; mt < 4; ++mt) vaf[ks][mt] = *(const bf16x8*)(VTC + s.base + (size_t)(h * 64 + mt * 16 + fr) * s.T + s.t + so);
    }
    {
        const float* __restrict__ G = (const float*)(p.ws + OFF_G);
        float graw_i = 0.f, graw_f = 0.f;
        if (tid < 128) { const float* gr = G + (size_t)(tok0 + tid) * 16 + dir * 8; graw_i = gr[h]; graw_f = gr[4 + h]; }
        const float bgi = p.b_gate[l * 16 + dir * 8 + h], bgf = p.b_gate[l * 16 + dir * 8 + 4 + h];
        __builtin_amdgcn_sched_barrier(0);
        __syncthreads();
        if (tid < 128) { gi[tid] = graw_i + bgi; gf[tid] = logsigmoidf_(graw_f + bgf); }
        __syncthreads();
        if (tid < 64) {
            const int ln = get_tid();
            int t0, t1;
            if (!dir) { t0 = 2 * ln; t1 = 2 * ln + 1; } else { t0 = 127 - 2 * ln; t1 = 126 - 2 * ln; }
            const float a = gf[t0], b2 = gf[t1];
            float sacc = a + b2;
#pragma unroll
            for (int o = 1; o < 64; o <<= 1) { float v = shi(sacc, ln - o); if (ln >= o) sacc += v; }
            bc[t1] = sacc; bc[t0] = sacc - b2;
        }
        __syncthreads();
    }
    const float bend = dir ? bc[0] : bc[127];
    if (tid < 64) {
        const int lane = get_tid();
        const float a0 = bend - bc[tid] + gi[tid], a1 = bend - bc[tid + 64] + gi[tid + 64];
        float m = fmaxf(a0, a1);
#pragma unroll
        for (int o = 32; o >= 1; o >>= 1) m = fmaxf(m, shx(m, o, lane));
        wv[tid] = __expf(a0 - m); wv[tid + 64] = __expf(a1 - m);
        if (tid == 0) sc[0] = m;
    }
    __syncthreads();
    f32x4 acc[5];
#pragma unroll
    for (int mt = 0; mt < 5; ++mt) acc[mt] = (f32x4){0.f, 0.f, 0.f, 0.f};
#pragma unroll
    for (int ks = 0; ks < 4; ++ks) {
        const int so = ks * 32 + fq * 8;
        const bf16x8 kb = kbf[ks];
        float wl[8];
#pragma unroll
        for (int e = 0; e < 8; ++e) wl[e] = wv[so + e];
#pragma unroll
        for (int mt = 0; mt < 4; ++mt) {
            const bf16x8 va = vaf[ks][mt];
            bf16x8 a;
#pragma unroll
            for (int e = 0; e < 8; ++e) a[e] = (short)f2bf(bfs2f(va[e]) * wl[e]);
            acc[mt] = mfma16(a, kb, acc[mt]);
        }
        bf16x8 a1;
#pragma unroll
        for (int e = 0; e < 8; ++e) a1[e] = (fr == 0) ? (short)f2bf(wl[e]) : (short)0;
        acc[4] = mfma16(a1, kb, acc[4]);
    }
#pragma unroll
    for (int mt = 0; mt < 5; ++mt)
#pragma unroll
        for (int j = 0; j < 4; ++j) Ub[(size_t)unit * 5120 + (mt * 16 + fq * 4 + j) * 64 + 16 * w + fr] = acc[mt][j];
    if (tid == 0) { Usc[unit * 2] = sc[0]; Usc[unit * 2 + 1] = bend; }
}

__device__ __forceinline__ void c2_task(const Params& p, int task) {
    const float* __restrict__ Ub = (const float*)(p.ws + OFF_UB);
    const float* __restrict__ Usc = (const float*)(p.ws + OFF_USC);
    bf16_t* __restrict__ Sb = (bf16_t*)(p.ws + OFF_SB);
    float* Mb = (float*)(p.ws + OFF_MB);
    const int tidx = get_tid();
    const int chain = task / 20, sub = task % 20, el = sub * 256 + tidx;
    float S = 0.f, m = 0.f;
    float ubv[18], mlv[18], bev[18];
#pragma unroll
    for (int kk = 0; kk < 18; ++kk) {
        const int unit = chain * 18 + kk;
        ubv[kk] = Ub[(size_t)unit * 5120 + el]; mlv[kk] = Usc[unit * 2]; bev[kk] = Usc[unit * 2 + 1];
    }
    __builtin_amdgcn_sched_barrier(0);
#pragma unroll
    for (int kk = 0; kk < 18; ++kk) {
        const int unit = chain * 18 + kk;
        Sb[(size_t)unit * 5120 + el] = f2bf(S);
        if (sub == 0 && tidx == 0) Mb[unit] = m;
        const float mloc = mlv[kk], bend = bev[kk];
        const float mnew = fmaxf(bend + m, mloc);
        S = __expf(bend + m - mnew) * S + __expf(mloc - mnew) * ubv[kk];
        m = mnew;
    }
}

__device__ __forceinline__ void c3_unit(const Params& p, int l, int b, int h, int isctx, int chunk, char* lds) {
    const bf16_t* __restrict__ P = (const bf16_t*)(p.ws + OFF_P);
    const bf16_t* __restrict__ VTC = (const bf16_t*)(p.ws + OFF_VTC);
    const bf16_t* Qc = (const bf16_t*)(p.ws + OFF_QC);
    const bf16_t* Kc = (const bf16_t*)(p.ws + OFF_KC);
    const bf16_t* Sb = (const bf16_t*)(p.ws + OFF_SB);
    const float* Mb = (const float*)(p.ws + OFF_MB);
    bf16_t* __restrict__ MIX = (bf16_t*)(p.ws + OFF_HM);
    const int tid = get_tid(), lane = tid & 63, w = tid >> 6, fr = lane & 15, fq = lane >> 4;
    const int tok0 = isctx ? NLAT + b * 256 + chunk * 128 : b * 2048 + chunk * 128;
    const SeqInfo s = seqinfo(tok0);
    float* gi = (float*)lds; float* gf = gi + 128; float* bc = gf + 128; float* av = bc + 128; float* Mx = av + 128;
    float* hsb = (float*)(lds + 4096);
    for (int dir = 0; dir < 2; ++dir) {
        const int kk = isctx ? (dir ? 1 - chunk : chunk) : (dir ? 17 - chunk : chunk + 2);
        const int unit = ((b * 4 + h) * 2 + dir) * 18 + kk;
        const float m_prev = Mb[unit];
        load_gates(p, l, tok0, h, dir, gi, gf, bc);
        if (tid < 64) {
            const int tid = get_tid();
            int t0, t1;
            if (!dir) { t0 = 2 * tid; t1 = 2 * tid + 1; } else { t0 = 127 - 2 * tid; t1 = 126 - 2 * tid; }
            const float a0 = gi[t0] - bc[t0], a1 = gi[t1] - bc[t1];
            av[t0] = a0; av[t1] = a1;
            float mm = fmaxf(a0, a1);
#pragma unroll
            for (int o = 1; o < 64; o <<= 1) { float v = shi(mm, tid - o); if (tid >= o) mm = fmaxf(mm, v); }
            float prev = shi(mm, tid - 1);
            if (tid == 0) prev = -3e38f;
            Mx[t1] = fmaxf(mm, m_prev);
            Mx[t0] = fmaxf(fmaxf(prev, a0), m_prev);
        }
        __syncthreads();
#pragma unroll 1
        for (int ti = 0; ti < 2; ++ti) {
            const int trow = w * 32 + ti * 16;
            const int tt = trow + fr;
            const bf16_t* qp = Qc + (size_t)(tok0 + tt) * 256 + h * 64 + fq * 8;
            const bf16x8 q0 = *(const bf16x8*)qp, q1 = *(const bf16x8*)(qp + 32);
            const float Mt = Mx[tt];
            bf16x8 ka[8][2], vbf[4][4];
#pragma unroll
            for (int st = 0; st < 8; ++st) {
                const bf16_t* kp = Kc + (size_t)(tok0 + st * 16 + fr) * 256 + h * 64 + fq * 8;
                ka[st][0] = *(const bf16x8*)kp; ka[st][1] = *(const bf16x8*)(kp + 32);
            }
            __builtin_amdgcn_sched_barrier(0);
            f32x4 wt[8];
            float dsum = 0.f;
#pragma unroll
            for (int st = 0; st < 8; ++st) {
                f32x4 acc = (f32x4){0.f, 0.f, 0.f, 0.f};
                acc = mfma16(ka[st][0], q0, acc);
                acc = mfma16(ka[st][1], q1, acc);
#pragma unroll
                for (int j = 0; j < 4; ++j) {
                    const int ss = st * 16 + fq * 4 + j;
                    const bool ok = dir ? (ss >= tt) : (ss <= tt);
                    const float wg = ok ? __expf(av[ss] - Mt) : 0.f;
                    const float v = acc[j] * wg;
                    wt[st][j] = v; dsum += v;
                }
            }
#pragma unroll
            for (int i = 0; i < 4; ++i)
#pragma unroll
                for (int ne = 0; ne < 4; ++ne) {
                    const bf16_t* vp = VTC + s.base + (size_t)(h * 64 + ne * 16 + fr) * s.T + s.t + i * 32 + 4 * fq;
                    vbf[i][ne] = cat4(*(const bf16x4*)vp, *(const bf16x4*)(vp + 16));
                }
            bf16x8 sbf[5][2];
#pragma unroll
            for (int ne = 0; ne < 5; ++ne) {
                const bf16_t* sp = Sb + (size_t)unit * 5120 + (ne * 16 + fr) * 64 + fq * 8;
                sbf[ne][0] = *(const bf16x8*)sp; sbf[ne][1] = *(const bf16x8*)(sp + 32);
            }
            __builtin_amdgcn_sched_barrier(0);
            dsum += shx(dsum, 16, lane);
            dsum += shx(dsum, 32, lane);
            f32x4 nm[4];
#pragma unroll
            for (int ne = 0; ne < 4; ++ne) nm[ne] = (f32x4){0.f, 0.f, 0.f, 0.f};
#pragma unroll
            for (int i = 0; i < 4; ++i) {
                const bf16x8 pa = packw(wt[2 * i], wt[2 * i + 1]);
#pragma unroll
                for (int ne = 0; ne < 4; ++ne) nm[ne] = mfma16(pa, vbf[i][ne], nm[ne]);
            }
            f32x4 qc[5];
#pragma unroll
            for (int ne = 0; ne < 5; ++ne) {
                f32x4 a = (f32x4){0.f, 0.f, 0.f, 0.f};
                a = mfma16(q0, sbf[ne][0], a);
                a = mfma16(q1, sbf[ne][1], a);
                qc[ne] = a;
            }
            f32x4 hv[4];
#pragma unroll
            for (int j = 0; j < 4; ++j) {
                const int tl = fq * 4 + j, t = trow + tl;
                const float Mv = Mx[t];
                const float wi = __expf(m_prev - Mv);
                const float mt_ = bc[t] + Mv;
                const float den = shi(dsum, tl) + wi * shi(qc[4][j], lane & 48);
                const float dn = fmaxf(fabsf(den), __expf(-mt_));
                const float idn = __builtin_amdgcn_rcpf(dn);
#pragma unroll
                for (int ne = 0; ne < 4; ++ne) hv[ne][j] = (nm[ne][j] + wi * qc[ne][j]) * idn;
            }
            if (dir == 0) {
#pragma unroll
                for (int ne = 0; ne < 4; ++ne)
#pragma unroll
                    for (int j = 0; j < 4; ++j) hsb[(ti * 16 + ne * 4 + j) * 256 + tid] = hv[ne][j];
            } else {
#pragma unroll
                for (int ne = 0; ne < 4; ++ne)
#pragma unroll
                    for (int j = 0; j < 4; ++j) hv[ne][j] += hsb[(ti * 16 + ne * 4 + j) * 256 + tid];
                bf16_t ograw[4][4];
#pragma unroll
                for (int j = 0; j < 4; ++j)
#pragma unroll
                    for (int ne = 0; ne < 4; ++ne) ograw[j][ne] = P[(size_t)(tok0 + trow + fq * 4 + j) * PW + 1536 + h * 64 + ne * 16 + fr];
                __builtin_amdgcn_sched_barrier(0);
#pragma unroll
                for (int j = 0; j < 4; ++j) {
                    const int t = trow + fq * 4 + j;
                    float sm = hv[0][j] + hv[1][j] + hv[2][j] + hv[3][j];
#pragma unroll
                    for (int o = 1; o < 16; o <<= 1) sm += shx(sm, o, lane);
                    const float mu = sm * (1.f / 64.f);
                    float vr = 0.f;
#pragma unroll
                    for (int ne = 0; ne < 4; ++ne) { float dlt = hv[ne][j] - mu; vr += dlt * dlt; }
#pragma unroll
                    for (int o = 1; o < 16; o <<= 1) vr += shx(vr, o, lane);
                    const float rstd = rsqrtf(vr * (1.f / 64.f) + 1e-6f);
#pragma unroll
                    for (int ne = 0; ne < 4; ++ne) {
                        const int e = h * 64 + ne * 16 + fr;
                        const float y = (hv[ne][j] - mu) * rstd * p.g_mlstm[l * 256 + e];
                        const float og = sigmoidf_(bf2f(ograw[j][ne]));
                        MIX[(size_t)(tok0 + t) * 1024 + 512 + e] = f2bf(og * y);
                    }
                }
            }
        }
    }
}


__device__ __forceinline__ void c3_unit2(const Params& p, int l, int b, int h, int isctx, int chunk, char* lds) {
    const bf16_t* __restrict__ P = (const bf16_t*)(p.ws + OFF_P);
    const bf16_t* __restrict__ VTC = (const bf16_t*)(p.ws + OFF_VTC);
    const bf16_t* __restrict__ Qc = (const bf16_t*)(p.ws + OFF_QC);
    const bf16_t* __restrict__ Kc = (const bf16_t*)(p.ws + OFF_KC);
    const bf16_t* __restrict__ Sb = (const bf16_t*)(p.ws + OFF_SB);
    const float* __restrict__ Mb = (const float*)(p.ws + OFF_MB);
    const float* __restrict__ G = (const float*)(p.ws + OFF_G);
    bf16_t* __restrict__ MIX = (bf16_t*)(p.ws + OFF_HM);
    const int tid = get_tid(), lane = tid & 63, w = __builtin_amdgcn_readfirstlane(tid >> 6), fr = lane & 15, fq = lane >> 4;
    const int tok0 = isctx ? NLAT + b * 256 + chunk * 128 : b * 2048 + chunk * 128;
    const SeqInfo s = seqinfo(tok0);
    float* gi = (float*)lds; float* gf = gi + 128; float* bc = gf + 128; float* av = bc + 128; float* Mx = av + 128;
    float* hsb = (float*)(lds + 4096);
    const char* kst = lds + 36864;
    const char* vst = lds + 53248;
    const unsigned lbase = (unsigned)(size_t)(lds_ptr_t)lds;
    __syncthreads();
#pragma unroll
    for (int i = 0; i < 4; ++i) {
        const int pc = w * 4 + i;
        const int sc = (lane & 7) ^ (((pc & 1) * 4 + (lane >> 4)) & 7);
        glds16((const void*)(Kc + (size_t)(tok0 + pc * 8 + (lane >> 3)) * 256 + h * 64 + sc * 8), lbase + 36864 + pc * 1024);
    }
#pragma unroll
    for (int i = 0; i < 4; ++i) {
        const int pc = w * 4 + i;
        const int e = pc * 4 + (lane >> 4), cp = lane & 15;
        glds16((const void*)(VTC + s.base + (size_t)(h * 64 + e) * s.T + s.t + ((cp ^ (e & 15)) << 3)), lbase + 53248 + pc * 1024);
    }
    for (int dir = 0; dir < 2; ++dir) {
        const int kk = isctx ? (dir ? 1 - chunk : chunk) : (dir ? 17 - chunk : chunk + 2);
        const int unit = ((b * 4 + h) * 2 + dir) * 18 + kk;
        const float m_prev = Mb[unit];
        float graw_i = 0.f, graw_f = 0.f;
        if (tid < 128) { const float* gr = G + (size_t)(tok0 + tid) * 16 + dir * 8; graw_i = gr[h]; graw_f = gr[4 + h]; }
        bf16x8 qf[2][2], sbf[5][2];
#pragma unroll
        for (int ti = 0; ti < 2; ++ti) {
            const bf16_t* qp = Qc + (size_t)(tok0 + w * 32 + ti * 16 + fr) * 256 + h * 64 + fq * 8;
            qf[ti][0] = *(const bf16x8*)qp; qf[ti][1] = *(const bf16x8*)(qp + 32);
        }
#pragma unroll
        for (int ne = 0; ne < 5; ++ne) {
            const bf16_t* sp = Sb + (size_t)unit * 5120 + (ne * 16 + fr) * 64 + fq * 8;
            sbf[ne][0] = *(const bf16x8*)sp; sbf[ne][1] = *(const bf16x8*)(sp + 32);
        }
        const float bgi = p.b_gate[l * 16 + dir * 8 + h], bgf = p.b_gate[l * 16 + dir * 8 + 4 + h];
        __builtin_amdgcn_sched_barrier(0);
        __syncthreads();
        if (tid < 128) { gi[tid] = graw_i + bgi; gf[tid] = logsigmoidf_(graw_f + bgf); }
        __syncthreads();
        if (tid < 64) {
            const int ln = get_tid();
            int t0, t1;
            if (!dir) { t0 = 2 * ln; t1 = 2 * ln + 1; } else { t0 = 127 - 2 * ln; t1 = 126 - 2 * ln; }
            const float a = gf[t0], b2 = gf[t1];
            float sacc = a + b2;
#pragma unroll
            for (int o = 1; o < 64; o <<= 1) { float v = shi(sacc, ln - o); if (ln >= o) sacc += v; }
            const float bc1 = sacc, bc0 = sacc - b2;
            bc[t1] = bc1; bc[t0] = bc0;
            const float a0 = gi[t0] - bc0, a1 = gi[t1] - bc1;
            av[t0] = a0; av[t1] = a1;
            float mm = fmaxf(a0, a1);
#pragma unroll
            for (int o = 1; o < 64; o <<= 1) { float v = shi(mm, ln - o); if (ln >= o) mm = fmaxf(mm, v); }
            float prev = shi(mm, ln - 1);
            if (ln == 0) prev = -3e38f;
            Mx[t1] = fmaxf(mm, m_prev);
            Mx[t0] = fmaxf(fmaxf(prev, a0), m_prev);
        }
        asm volatile("s_waitcnt vmcnt(0)" ::: "memory");
        __syncthreads();
#pragma unroll
        for (int ti = 0; ti < 2; ++ti) {
            const int trow = w * 32 + ti * 16;
            const int tt = trow + fr;
            const bf16x8 q0 = qf[ti][0], q1 = qf[ti][1];
            const float Mt = Mx[tt];
            f32x4 nm[4];
#pragma unroll
            for (int ne = 0; ne < 4; ++ne) nm[ne] = (f32x4){0.f, 0.f, 0.f, 0.f};
            float dsum = 0.f;
#pragma unroll
            for (int hf = 0; hf < 2; ++hf) {
                f32x4 wt[4];
#pragma unroll
                for (int s4 = 0; s4 < 4; ++s4) {
                    const int st = hf * 4 + s4;
                    const int tokidx = st * 16 + fr, sw = (tokidx >> 1) & 7;
                    const bf16x8 k0 = *(const bf16x8*)(kst + tokidx * 128 + ((fq ^ sw) << 4));
                    const bf16x8 k1 = *(const bf16x8*)(kst + tokidx * 128 + (((4 + fq) ^ sw) << 4));
                    f32x4 acc = (f32x4){0.f, 0.f, 0.f, 0.f};
                    acc = mfma16(k0, q0, acc);
                    acc = mfma16(k1, q1, acc);
#pragma unroll
                    for (int j = 0; j < 4; ++j) {
                        const int ss = st * 16 + fq * 4 + j;
                        const bool ok = dir ? (ss >= tt) : (ss <= tt);
                        const float wg = ok ? __expf(av[ss] - Mt) : 0.f;
                        const float v = acc[j] * wg;
                        wt[s4][j] = v; dsum += v;
                    }
                }
#pragma unroll
                for (int i2 = 0; i2 < 2; ++i2) {
                    const int i = hf * 2 + i2;
                    const bf16x8 pa = packw(wt[2 * i2], wt[2 * i2 + 1]);
                    const int tl = i * 32 + 4 * fq, tl2 = tl + 16;
#pragma unroll
                    for (int ne = 0; ne < 4; ++ne) {
                        const int e = ne * 16 + fr;
                        const char* row = vst + e * 256;
                        const bf16x4 v0 = *(const bf16x4*)(row + (((tl >> 3) ^ (e & 15)) << 4) + (tl & 7) * 2);
                        const bf16x4 v1 = *(const bf16x4*)(row + (((tl2 >> 3) ^ (e & 15)) << 4) + (tl2 & 7) * 2);
                        nm[ne] = mfma16(pa, cat4(v0, v1), nm[ne]);
                    }
                }
            }
            dsum += shx(dsum, 16, lane);
            dsum += shx(dsum, 32, lane);
            f32x4 qc[5];
#pragma unroll
            for (int ne = 0; ne < 5; ++ne) {
                f32x4 a = (f32x4){0.f, 0.f, 0.f, 0.f};
                a = mfma16(q0, sbf[ne][0], a);
                a = mfma16(q1, sbf[ne][1], a);
                qc[ne] = a;
            }
            f32x4 hv[4];
#pragma unroll
            for (int j = 0; j < 4; ++j) {
                const int tl = fq * 4 + j, t = trow + tl;
                const float Mv = Mx[t];
                const float wi = __expf(m_prev - Mv);
                const float mt_ = bc[t] + Mv;
                const float den = shi(dsum, tl) + wi * shi(qc[4][j], lane & 48);
                const float dn = fmaxf(fabsf(den), __expf(-mt_));
                const float idn = __builtin_amdgcn_rcpf(dn);
#pragma unroll
                for (int ne = 0; ne < 4; ++ne) hv[ne][j] = (nm[ne][j] + wi * qc[ne][j]) * idn;
            }
            if (dir == 0) {
#pragma unroll
                for (int ne = 0; ne < 4; ++ne)
#pragma unroll
                    for (int j = 0; j < 4; ++j) hsb[(ti * 16 + ne * 4 + j) * 256 + tid] = hv[ne][j];
            } else {
                bf16_t ograw[4][4];
#pragma unroll
                for (int j = 0; j < 4; ++j)
#pragma unroll
                    for (int ne = 0; ne < 4; ++ne) ograw[j][ne] = P[(size_t)(tok0 + trow + fq * 4 + j) * PW + 1536 + h * 64 + ne * 16 + fr];
                __builtin_amdgcn_sched_barrier(0);
#pragma unroll
                for (int ne = 0; ne < 4; ++ne)
#pragma unroll
                    for (int j = 0; j < 4; ++j) hv[ne][j] += hsb[(ti * 16 + ne * 4 + j) * 256 + tid];
#pragma unroll
                for (int j = 0; j < 4; ++j) {
                    const int t = trow + fq * 4 + j;
                    float sm = hv[0][j] + hv[1][j] + hv[2][j] + hv[3][j];
#pragma unroll
                    for (int o = 1; o < 16; o <<= 1) sm += shx(sm, o, lane);
                    const float mu = sm * (1.f / 64.f);
                    float vr = 0.f;
#pragma unroll
                    for (int ne = 0; ne < 4; ++ne) { float dlt = hv[ne][j] - mu; vr += dlt * dlt; }
#pragma unroll
                    for (int o = 1; o < 16; o <<= 1) vr += shx(vr, o, lane);
                    const float rstd = rsqrtf(vr * (1.f / 64.f) + 1e-6f);
#pragma unroll
                    for (int ne = 0; ne < 4; ++ne) {
                        const int e = h * 64 + ne * 16 + fr;
                        const float y = (hv[ne][j] - mu) * rstd * p.g_mlstm[l * 256 + e];
                        const float og = sigmoidf_(bf2f(ograw[j][ne]));
                        MIX[(size_t)(tok0 + t) * 1024 + 512 + e] = f2bf(og * y);
                    }
                }
            }
        }
    }
}

#define XB_TMO      128
#define XB_XCNT(j)  (256  + 64 * (j))
#define XB_XSUB(j)  (1280 + 64 * (j))
#define XB_XGEN(j)  (2304 + 64 * (j))
#define XB_TOP      3328
#define XB_TOPGEN   3392
#define XCD_BAR_WORDS 3456
#define XB_SPIN_CAP (1u << 22)
#define LAS __attribute__((address_space(3)))
__device__ __forceinline__ unsigned xb_ld(unsigned* p) { return __hip_atomic_load(p, __ATOMIC_RELAXED, __HIP_MEMORY_SCOPE_AGENT); }
__device__ __forceinline__ unsigned xb_add(unsigned* p, unsigned v) { return __hip_atomic_fetch_add(p, v, __ATOMIC_RELAXED, __HIP_MEMORY_SCOPE_AGENT); }
__device__ __forceinline__ unsigned xb_xcc_id() { return (unsigned)__builtin_amdgcn_s_getreg((3 << 11) | 20) & 0xFu; }
#define XB_SPIN(cond, bar) do { unsigned _sp = 0; while (cond) { __builtin_amdgcn_s_sleep(1); \
    if ((++_sp & 255u) == 0u) { if (xb_ld(&(bar)[XB_TMO])) break; if (_sp > XB_SPIN_CAP) { atomicAdd(&(bar)[XB_TMO], 1u); break; } } } } while (0)
struct XcdBarrier { unsigned* bar; unsigned x; volatile LAS unsigned* st; };
__device__ __forceinline__ XcdBarrier xcd_barrier_post(unsigned* bar, volatile LAS unsigned* st) {
    XcdBarrier b; b.bar = bar; b.x = xb_xcc_id(); b.st = st;
    if (threadIdx.x == 0) (void)xb_add(&bar[XB_XCNT(b.x)], 1u);
    return b;
}
__device__ __forceinline__ void xcd_barrier_complete(unsigned* bar, unsigned x, unsigned& nloc, unsigned& nx) {
    const unsigned G = gridDim.x * gridDim.y * gridDim.z;
    unsigned sum, cnt, mine, sp = 0u;
    for (;;) {
        sum = 0u; cnt = 0u; mine = 0u;
#pragma unroll
        for (unsigned j = 0; j < 16; ++j) { const unsigned c = xb_ld(&bar[XB_XCNT(j)]); sum += c; cnt += (c > 0u) ? 1u : 0u; mine = (j == x) ? c : mine; }
        if (sum == G) break;
        __builtin_amdgcn_s_sleep(1);
        if ((++sp & 255u) == 0u) { if (xb_ld(&bar[XB_TMO])) break; if (sp > XB_SPIN_CAP) { atomicAdd(&bar[XB_TMO], 1u); break; } }
    }
    nloc = mine > 0u ? mine : 1u; nx = cnt > 0u ? cnt : 1u;
}
__device__ __forceinline__ void xcd_barrier(const XcdBarrier& b) {
    asm volatile("s_waitcnt vmcnt(0)" ::: "memory");
    __syncthreads();
    if (threadIdx.x == 0) {
        unsigned* bar = b.bar;
        __builtin_amdgcn_s_waitcnt(0);
        unsigned nloc = b.st[0], nx = b.st[1];
        if (nloc == 0u) { xcd_barrier_complete(bar, b.x, nloc, nx); b.st[0] = nloc; b.st[1] = nx; }
        const unsigned old = xb_add(&bar[XB_XSUB(b.x)], 1u);
        const unsigned gen = old / nloc;
        if (old + 1u == (gen + 1u) * nloc) {
            __builtin_amdgcn_fence(__ATOMIC_RELEASE, "agent");
            asm volatile("s_waitcnt vmcnt(0)" ::: "memory");
            const unsigned og = xb_add(&bar[XB_TOP], 1u);
            const unsigned tg = og / nx;
            if (og + 1u == (tg + 1u) * nx) xb_add(&bar[XB_TOPGEN], 1u);
            else XB_SPIN(xb_ld(&bar[XB_TOPGEN]) == tg, bar);
            __builtin_amdgcn_fence(__ATOMIC_ACQUIRE, "agent");
            xb_add(&bar[XB_XGEN(b.x)], 1u);
            asm volatile("s_waitcnt vmcnt(0)" ::: "memory");
        } else {
            XB_SPIN(xb_ld(&bar[XB_XGEN(b.x)]) == gen, bar);
            __builtin_amdgcn_fence(__ATOMIC_ACQUIRE, "agent");
            asm volatile("s_waitcnt vmcnt(0)" ::: "memory");
        }
    }
    __syncthreads();
}
__device__ __forceinline__ bool tile_map(int it, int MT, int NT, int& mt, int& nt) {
    const int xcd = blockIdx.x & 7, j = blockIdx.x >> 3, SR = (int)(gridDim.x >> 6);
    const int ncg = (NT + 7) >> 3, nrg = (MT + SR - 1) / SR;
    const int s = xcd + 8 * it;
    if (s >= nrg * ncg) return false;
    const int rg = s / ncg, cgi = s - rg * ncg;
    mt = rg * SR + (j >> 3); nt = cgi * 8 + (j & 7);
    return true;
}

__device__ __forceinline__ bool next_tile(int& it, int MT, int NT, int& mt, int& nt) {
    while (tile_map(it, MT, NT, mt, nt)) { if (mt < MT && nt < NT) return true; ++it; }
    return false;
}
#ifndef REP_GEMM
#define REP_GEMM 1
#endif
#ifndef REP_MIX
#define REP_MIX 1
#endif
#ifndef RA
#define RA 1
#endif
#ifndef RG
#define RG 1
#endif
#ifndef RP
#define RP 1
#endif
#ifndef REP_C3
#define REP_C3 1
#endif
#ifndef REP_NORM
#define REP_NORM 1
#endif
#ifndef REP_PRO
#define REP_PRO 1
#endif
#ifndef REP_MISC
#define REP_MISC 1
#endif
__global__ void __launch_bounds__(NTHREADS, 2) mega_kernel(Params p) {
    cg::grid_group grid = cg::this_grid();
    extern __shared__ __attribute__((aligned(16))) char lds[];
    const int nblk = gridDim.x, bid = blockIdx.x;
    if (threadIdx.x == 0) { *(u32x4*)(lds + LDS_BYTES) = (u32x4){0u, 0u, 0u, 0u}; }
    __syncthreads();
    XcdBarrier xb = xcd_barrier_post((unsigned*)(p.ws + OFF_BAR), (volatile LAS unsigned*)(lds + LDS_BYTES));
    bf16_t* WinT = (bf16_t*)(p.ws + OFF_WIN);
    bf16_t* WoutT = (bf16_t*)(p.ws + OFF_WOUT);
    bf16_t* W1T = (bf16_t*)(p.ws + OFF_W1);
    bf16_t* W2T = (bf16_t*)(p.ws + OFF_W2);
    bf16_t* HM = (bf16_t*)(p.ws + OFF_HM);
    float* ctxres = (float*)(p.ws + OFF_CTXRES);
    const float* modall = (const float*)(p.ws + OFF_MOD);

    for (int rep = 0; rep < REP_PRO; ++rep) {
    prologue_phase(p, lds);
    if (p.ws == nullptr) grid.sync();
    xcd_barrier(xb);
    }
    for (int l = 0; l < 2; ++l) {
        const bool last = (l == 1);
        const float* srcLat = l == 0 ? p.x : p.out;
        const float* srcCtx = l == 0 ? p.ctx : ctxres;
        for (int rep = 0; rep < REP_NORM; ++rep) {
        norm_phase(p, l, srcLat, srcCtx, p.g_mix + l * 1024, 0, 1, NTOK, l == 1 ? (const float*)(p.ws + OFF_CPART) : nullptr);
        xcd_barrier(xb);
        }
        for (int rep = 0; rep < REP_GEMM; ++rep) {
            EpiIn epi;
            epi.P = (bf16_t*)(p.ws + OFF_P); epi.VTA = (bf16_t*)(p.ws + OFF_VTA); epi.VTC = (bf16_t*)(p.ws + OFF_VTC);
            epi.FT = (bf16_t*)(p.ws + OFF_FT); epi.G = (float*)(p.ws + OFF_G);
            const int nbx = (int)(gridDim.x >> 3), xg = bid & 7, jb = bid >> 3;
            constexpr int TOT = (NTOK / 256) * 23, PERX = TOT / 8;
            const int nround = PERX / nbx, nrem = PERX - nround * nbx;
            auto tile_of = [&](int idx, int& tm, int& tn) {
                const int g = xg * PERX + idx, rg = g / 184; int r = g - rg * 184;
                if (r < 128) { tm = rg * 8 + ((r & 63) >> 3); tn = (r >> 6) * 8 + (r & 7); }
                else { r -= 128; tm = rg * 8 + r / 7; tn = 16 + r % 7; }
            };
            const bf16_t* Wl = WinT + (size_t)l * NPAD * 1024;
            bool pref = false;
            for (int rd = 0; rd < nround; ++rd) {
                int mt, nt, mt2 = 0, nt2 = 0;
                tile_of(rd * nbx + jb, mt, nt);
                const bool have2 = (rd + 1 < nround);
                if (have2) tile_of((rd + 1) * nbx + jb, mt2, nt2);
                if (nt >= 14 && nt < 22) gemm_tile_ring<8, false>(HM, 1024, Wl, 1024, 1024, mt * 256, nt * 128, lds, epi, pref, have2, mt2 * 256, nt2 * 128);
                else gemm_tile_ring<8, true>(HM, 1024, Wl, 1024, 1024, mt * 256, nt * 128, lds, epi, pref, have2, mt2 * 256, nt2 * 128);
                pref = have2;
            }
            for (int sidx = jb; sidx < 2 * nrem; sidx += nbx) {
                int mt, nt;
                tile_of(nround * nbx + (sidx >> 1), mt, nt);
                const int m0s = mt * 256 + (sidx & 1) * 128;
                if (nt >= 14 && nt < 22) gemm_tile_ring<4, false>(HM, 1024, Wl, 1024, 1024, m0s, nt * 128, lds, epi, false, false, 0, 0);
                else gemm_tile_ring<4, true>(HM, 1024, Wl, 1024, 1024, m0s, nt * 128, lds, epi, false, false, 0, 0);
            }
            xcd_barrier(xb);
        }
        {
            const int n_dft = 256, n_gmlp = last ? 256 : 288, n_attn = 2048, n_attc = last ? 0 : 256, n_dftc = last ? 0 : 64, n_mid = 64, n_prep = NTOK / 32;
            const int e1 = n_dft, e2 = e1 + n_gmlp, e3 = e2 + n_attn, e4 = e3 + n_attc, e5 = e4 + n_dftc, e6 = e5 + n_mid, e7 = e6 + n_prep;
            unsigned* qctr = (unsigned*)(p.ws + OFF_BAR) + 3456 + l;
            int* slot = (int*)(lds + LDS_BYTES - 16);
            for (;;) {
                __syncthreads();
                if (threadIdx.x == 0) *slot = (int)atomicAdd(qctr, 1u);
                __syncthreads();
                const int t = *slot;
                if (t >= e7) break;
                if (t < e1) {
                    const int xq = t & 7, jq = t >> 3, b = 2 * xq + (jq >> 4), mt = (jq >> 1) & 7, nt = jq & 1;
                    dft_sym_tile((const bf16_t*)(p.ws + OFF_TABL), (const bf16_t*)(p.ws + OFF_FT) + (size_t)b * 256 * 4096, HM, b, mt * 128, nt * 128, 0.00276213586400995f, lds);
                } else if (t < e2) gmlp_unit(p, l, t - e1, lds);
                else if (t < e3) attn_unit2<false>(p, l, t - e2, lds);
                else if (t < e4) attn_unit2<true>(p, l, t - e3, lds);
                else if (t < e5) {
                    const int q = t - e4, b = q >> 2, mt = (q >> 1) & 1, nt = q & 1;
                    EpiDFT epi; epi.MIX = HM; epi.tok0 = NLAT + b * 256; epi.scale = 0.0078125f;
                    gemm_tile<true>((const bf16_t*)(p.ws + OFF_TABC), 512, (const bf16_t*)(p.ws + OFF_FT) + (size_t)NLAT * 512 + (size_t)b * 256 * 512, 512, 512, mt * 128, nt * 128, lds, epi);
                } else if (t < e6) dft_mid_task((const bf16_t*)(p.ws + OFF_FT), HM, t - e5, 0.00276213586400995f);
                else { const int q = t - e6; for (int u4 = 0; u4 < 4; ++u4) prep_unit(p, l, q * 4 + u4); }
            }
            xcd_barrier(xb);
        }
        for (int rep = 0; rep < REP_MISC; ++rep) {
        for (int t = bid; t < NU; t += nblk) c1_unit(p, l, t, lds);
        xcd_barrier(xb);
        for (int t = bid; t < 128 * 20; t += nblk) c2_task(p, t);
        xcd_barrier(xb);
        }
        for (int rep = 0; rep < REP_C3; ++rep) {
            const int nun = last ? 64 * 16 : 64 * 18;
            for (int t = bid; t < nun; t += nblk) {
                int b, h, isctx, chunk;
                if (t < 1024) { b = t >> 6; h = (t >> 4) & 3; isctx = 0; chunk = t & 15; }
                else { const int q = t - 1024; b = q >> 3; h = (q >> 1) & 3; isctx = 1; chunk = q & 1; }
                c3_unit2(p, l, b, h, isctx, chunk, lds);
            }
            xcd_barrier(xb);
        }
        const int Mrows = last ? NLAT : NTOK;
        {
            EpiRes epi; epi.srcLat = srcLat; epi.srcCtx = srcCtx; epi.dstLat = p.out; epi.dstCtx = ctxres;
            epi.mod = modall + (size_t)l * 17 * 6144; epi.gidx = 2;
            int it = 0, mt, nt; bool have = next_tile(it, NLAT / 256, 8, mt, nt), pref = false;
            while (have) {
                int it2 = it + 1, mt2 = 0, nt2 = 0; const bool have2 = next_tile(it2, NLAT / 256, 8, mt2, nt2);
                gemm_tile_ring<8, true>(HM, 1024, WoutT + (size_t)l * 1024 * 1024, 1024, 1024, mt * 256, nt * 128, lds, epi, pref, have2, mt2 * 256, nt2 * 128);
                pref = have2; have = have2; it = it2; mt = mt2; nt = nt2;
            }
            if (!last) {
                int itc = 0, mtc, ntc;
                while (next_tile(itc, NCTX / 64, 8, mtc, ntc)) {
                    gemm_tile_ring<2, true>(HM, 1024, WoutT + (size_t)l * 1024 * 1024, 1024, 1024, NLAT + mtc * 64, ntc * 128, lds, epi, false, false, 0, 0);
                    ++itc;
                }
            }
        }
        xcd_barrier(xb);
        for (int rep = 0; rep < REP_NORM; ++rep) {
        norm_phase(p, l, p.out, ctxres, p.g_ffn + l * 1024, 3, 4, Mrows);
        xcd_barrier(xb);
        }
        for (int rep = 0; rep < REP_GEMM; ++rep) {
            EpiFF1 epi; epi.HID = (bf16_t*)(p.ws + OFF_HID);
            int it = 0, mt, nt; bool have = next_tile(it, Mrows / 256, 32, mt, nt), pref = false;
            while (have) {
                int it2 = it + 1, mt2 = 0, nt2 = 0; const bool have2 = next_tile(it2, Mrows / 256, 32, mt2, nt2);
                gemm_tile_ring<8, true>(HM, 1024, W1T + (size_t)l * 4096 * 1024, 1024, 1024, mt * 256, nt * 128, lds, epi, pref, have2, mt2 * 256, nt2 * 128);
                pref = have2; have = have2; it = it2; mt = mt2; nt = nt2;
            }
            xcd_barrier(xb);
        }
        {
            EpiRes epi; epi.srcLat = p.out; epi.srcCtx = ctxres; epi.dstLat = p.out; epi.dstCtx = ctxres;
            epi.mod = modall + (size_t)l * 17 * 6144; epi.gidx = 5;
            int it = 0, mt, nt; bool have = next_tile(it, NLAT / 256, 8, mt, nt), pref = false;
            while (have) {
                int it2 = it + 1, mt2 = 0, nt2 = 0; const bool have2 = next_tile(it2, NLAT / 256, 8, mt2, nt2);
                gemm_tile_ring<8, true>((const bf16_t*)(p.ws + OFF_HID), 4096, W2T + (size_t)l * 1024 * 4096, 4096, 4096, mt * 256, nt * 128, lds, epi, pref, have2, mt2 * 256, nt2 * 128);
                pref = have2; have = have2; it = it2; mt = mt2; nt = nt2;
            }
            if (!last) {
                int itc = 0, mtc, ntc;
                EpiPart epart; epart.part = (float*)(p.ws + OFF_CPART); epart.mod = modall + (size_t)l * 17 * 6144; epart.gidx = 5;
                while (next_tile(itc, 64, 8, mtc, ntc)) {
                    const int kh = mtc >> 5, mrow = NLAT + (mtc & 31) * 128;
                    const bf16_t* Ah = (const bf16_t*)(p.ws + OFF_HID) + kh * 2048;
                    const bf16_t* Bh = W2T + (size_t)l * 1024 * 4096 + kh * 2048;
                    if (kh == 0) gemm_tile_ring<4, true>(Ah, 4096, Bh, 4096, 2048, mrow, ntc * 128, lds, epi, false, false, 0, 0);
                    else gemm_tile_ring<4, true>(Ah, 4096, Bh, 4096, 2048, mrow, ntc * 128, lds, epart, false, false, 0, 0);
                    ++itc;
                }
            }
        }
        xcd_barrier(xb);
    }
    final_norm_phase(p);
}

extern "C" void kernel_launch(void* const* d_in, const int* in_sizes, int n_in, void* d_out, int out_size, void* d_ws, size_t ws_size,
                              hipStream_t stream) {
    static int grid_blocks = 0;
    if (!grid_blocks) {
        int dev = 0, cus = 0, per_cu = 0;
        (void)hipGetDevice(&dev);
        (void)hipDeviceGetAttribute(&cus, hipDeviceAttributeMultiprocessorCount, dev);
        (void)hipFuncSetAttribute((const void*)mega_kernel, hipFuncAttributeMaxDynamicSharedMemorySize, LDS_BYTES + 16);
        (void)hipOccupancyMaxActiveBlocksPerMultiprocessor(&per_cu, mega_kernel, NTHREADS, LDS_BYTES + 16);
        if (per_cu > 2) per_cu = 2;
        if (per_cu < 1) per_cu = 1;
        grid_blocks = cus * per_cu;
    }
    Params p{};
    p.x = (const float*)d_in[0]; p.c = (const float*)d_in[1]; p.ctx = (const float*)d_in[2]; p.c_ctx = (const float*)d_in[3];
    p.w_ada = (const float*)d_in[4]; p.b_ada = (const float*)d_in[5]; p.g_mix = (const float*)d_in[6]; p.g_ffn = (const float*)d_in[7];
    p.w_in = (const float*)d_in[8]; p.b_gate = (const float*)d_in[9]; p.w_conv = (const float*)d_in[10]; p.rpb = (const float*)d_in[11];
    p.w_sp = (const float*)d_in[12]; p.b_sp = (const float*)d_in[13]; p.g_gmlp = (const float*)d_in[14]; p.g_mlstm = (const float*)d_in[15];
    p.w_fnet = (const float*)d_in[16]; p.w_out = (const float*)d_in[17]; p.w_ff1 = (const float*)d_in[18]; p.w_ff2 = (const float*)d_in[19];
    p.g_final = (const float*)d_in[20];
    p.out = (float*)d_out;
    p.ws = (char*)d_ws;
    (void)hipMemsetAsync((char*)d_ws + OFF_BAR, 0, 3520 * 4, stream);
    void* args[] = {&p};
    hipError_t e = hipLaunchCooperativeKernel((void*)mega_kernel, dim3(grid_blocks), dim3(NTHREADS), args, LDS_BYTES + 16, stream);
    if (e != hipSuccess) fprintf(stderr, "cooperative launch failed: %s (grid %d)\n", hipGetErrorString(e), grid_blocks);
}
```

```cpp
#include <hip/hip_runtime.h>
#include <hip/hip_cooperative_groups.h>
#include <cstdio>
#include <cstdint>
namespace cg = cooperative_groups;

typedef unsigned short bf16_t;
typedef short bf16x8 __attribute__((ext_vector_type(8)));
typedef short bf16x4 __attribute__((ext_vector_type(4)));
typedef float f32x4 __attribute__((ext_vector_type(4)));
typedef unsigned u32x4 __attribute__((ext_vector_type(4)));
typedef unsigned u32x2 __attribute__((ext_vector_type(2)));

constexpr int D = 1024, NB = 16, SEQ = 2048, CTXL = 256;
constexpr int NLAT = NB * SEQ, NCTX = NB * CTXL, NTOK = NLAT + NCTX;
constexpr int NPAD = 2944, PW = 1792, DFF = 4096, DIN = 2576;
constexpr int NU = 128 * 18;
constexpr int NTHREADS = 256;
constexpr int LDS_BYTES = 73728;

constexpr size_t al256(size_t x) { return (x + 255) & ~(size_t)255; }
constexpr size_t OFF_WIN = 0;
constexpr size_t OFF_WOUT = OFF_WIN + al256((size_t)2 * NPAD * 1024 * 2);
constexpr size_t OFF_W1 = OFF_WOUT + al256((size_t)2 * 1024 * 1024 * 2);
constexpr size_t OFF_W2 = OFF_W1 + al256((size_t)2 * 4096 * 1024 * 2);
constexpr size_t OFF_WSP = OFF_W2 + al256((size_t)2 * 4096 * 1024 * 2);
constexpr size_t OFF_TABL = OFF_WSP + al256((size_t)2 * 4 * 128 * 128 * 2);
constexpr size_t OFF_TABC = OFF_TABL + al256((size_t)2048 * 4096 * 2);
constexpr size_t OFF_MOD = OFF_TABC + al256((size_t)256 * 512 * 2);
constexpr size_t OFF_CTXRES = OFF_MOD + al256((size_t)2 * 17 * 6144 * 4);
constexpr size_t OFF_HM = OFF_CTXRES + al256((size_t)NCTX * 1024 * 4);
constexpr size_t OFF_R = OFF_HM + al256((size_t)NTOK * 1024 * 2);
constexpr size_t OFF_P = OFF_R;
constexpr size_t OFF_G = OFF_P + al256((size_t)NTOK * PW * 2);
constexpr size_t OFF_VTA = OFF_G + al256((size_t)NTOK * 16 * 4);
constexpr size_t OFF_VTC = OFF_VTA + al256((size_t)NTOK * 256 * 2);
constexpr size_t OFF_FT = OFF_VTC + al256((size_t)NTOK * 256 * 2);
constexpr size_t OFF_QC = OFF_FT + al256((size_t)NTOK * 256 * 2 * 2);
constexpr size_t OFF_KC = OFF_QC + al256((size_t)NTOK * 256 * 2);
constexpr size_t OFF_KCT = OFF_KC + al256((size_t)NTOK * 256 * 2);
constexpr size_t OFF_UB = OFF_KCT + al256((size_t)NTOK * 256 * 2);
constexpr size_t OFF_USC = OFF_UB + al256((size_t)NU * 5120 * 4);
constexpr size_t OFF_SB = OFF_USC + al256((size_t)NU * 2 * 4);
constexpr size_t OFF_MB = OFF_SB + al256((size_t)NU * 5120 * 2);
constexpr size_t OFF_BAR = OFF_MB + al256((size_t)NU * 4);
constexpr size_t OFF_END = OFF_BAR + al256((size_t)3520 * 4);
constexpr size_t OFF_HID = OFF_R;
constexpr size_t OFF_CPART = OFF_HID + al256((size_t)NTOK * 4096 * 2);
static_assert(OFF_CPART + (size_t)NCTX * 1024 * 4 <= OFF_BAR, "context partial scratch must fit behind the hid overlay");
static_assert(OFF_HID + (size_t)NTOK * 4096 * 2 <= OFF_END, "hid overlay must fit");
static_assert(OFF_END <= (size_t)536870912, "workspace too large");

struct Params {
    const float *x, *c, *ctx, *c_ctx, *w_ada, *b_ada, *g_mix, *g_ffn, *w_in, *b_gate, *w_conv, *rpb, *w_sp, *b_sp,
        *g_gmlp, *g_mlstm, *w_fnet, *w_out, *w_ff1, *w_ff2, *g_final;
    float* out;
    char* ws;
};

__device__ __forceinline__ float shx(float v, int o, int lane) { return __int_as_float(__builtin_amdgcn_ds_bpermute((lane ^ o) << 2, __float_as_int(v))); }
__device__ __forceinline__ float shi(float v, int src) { return __int_as_float(__builtin_amdgcn_ds_bpermute((src & 63) << 2, __float_as_int(v))); }
__device__ __forceinline__ int get_tid() { int t = threadIdx.x; asm volatile("" : "+v"(t)); return t; }
__device__ __forceinline__ bf16_t f2bf(float f) { return __builtin_bit_cast(unsigned short, (__bf16)f); }
__device__ __forceinline__ float bf2f(bf16_t b) { return __uint_as_float(((unsigned)b) << 16); }
__device__ __forceinline__ float bfs2f(short b) { return __uint_as_float(((unsigned)(unsigned short)b) << 16); }
typedef __bf16 bf16v2_t __attribute__((ext_vector_type(2)));
__device__ __forceinline__ unsigned pack2(float lo, float hi) { bf16v2_t v; v[0] = (__bf16)lo; v[1] = (__bf16)hi; return __builtin_bit_cast(unsigned, v); }
__device__ __forceinline__ float gelu_tanh(float x) {
    float u = 0.7978845608028654f * (x + 0.044715f * x * x * x);
    float t = 1.f - 2.f * __builtin_amdgcn_rcpf(__expf(2.f * u) + 1.f);
    return 0.5f * x * (1.f + t);
}
__device__ __forceinline__ float sigmoidf_(float x) { return __builtin_amdgcn_rcpf(1.f + __expf(-x)); }
__device__ __forceinline__ float logsigmoidf_(float x) { return fminf(x, 0.f) - log1pf(__expf(-fabsf(x))); }
__device__ __forceinline__ f32x4 mfma16(bf16x8 a, bf16x8 b, f32x4 c) { return __builtin_amdgcn_mfma_f32_16x16x32_bf16(a, b, c, 0, 0, 0); }
__device__ __forceinline__ bf16x8 cat4(bf16x4 a, bf16x4 b) { return __builtin_shufflevector(a, b, 0, 1, 2, 3, 4, 5, 6, 7); }
__device__ __forceinline__ bf16x8 packw(f32x4 a, f32x4 b) {
    bf16x8 r;
    r[0] = (short)f2bf(a[0]); r[1] = (short)f2bf(a[1]); r[2] = (short)f2bf(a[2]); r[3] = (short)f2bf(a[3]);
    r[4] = (short)f2bf(b[0]); r[5] = (short)f2bf(b[1]); r[6] = (short)f2bf(b[2]); r[7] = (short)f2bf(b[3]);
    return r;
}
struct SeqInfo { size_t base; int T; int t; int b; };
__device__ __forceinline__ SeqInfo seqinfo(int tok) {
    SeqInfo s;
    if (tok < NLAT) { s.b = tok >> 11; s.t = tok & 2047; s.T = 2048; s.base = (size_t)s.b * 256 * 2048; }
    else { int j = tok - NLAT; s.b = j >> 8; s.t = j & 255; s.T = 256; s.base = (size_t)NLAT * 256 + (size_t)s.b * 256 * 256; }
    return s;
}

template <bool SWAP, class Epi>
__device__ __forceinline__ void gemm_tile(const bf16_t* __restrict__ A, size_t lda, const bf16_t* __restrict__ Bt, size_t ldb,
                                          int K, int m0, int n0, char* lds, const Epi& epi) {
    const int tid = get_tid(), lane = tid & 63, wid = tid >> 6, wr = wid >> 1, wc = wid & 1, fr = lane & 15, fq = lane >> 4;
    f32x4 acc[4][4];
#pragma unroll
    for (int i = 0; i < 4; ++i)
#pragma unroll
        for (int j = 0; j < 4; ++j) acc[i][j] = (f32x4){0.f, 0.f, 0.f, 0.f};
    const int lr = tid >> 3, lc = tid & 7;
    const bf16_t* ag = A + (size_t)(m0 + lr) * lda + lc * 8;
    const bf16_t* bg = Bt + (size_t)(n0 + lr) * ldb + lc * 8;
    char* wdst = lds + lr * 128 + ((lc ^ ((lr >> 1) & 7)) << 4);
    const int roff = (fq ^ (fr >> 1)) * 16;
    const char* ardb = lds + (wr * 64 + fr) * 128;
    const char* brdb = lds + 16384 + (wc * 64 + fr) * 128;
    u32x4 ra[4], rb[4];
#pragma unroll
    for (int j = 0; j < 4; ++j) { ra[j] = *(const u32x4*)(ag + (size_t)j * 32 * lda); rb[j] = *(const u32x4*)(bg + (size_t)j * 32 * ldb); }
    for (int k0 = 0; k0 < K; k0 += 64) {
        __syncthreads();
#pragma unroll
        for (int j = 0; j < 4; ++j) { *(u32x4*)(wdst + j * 4096) = ra[j]; *(u32x4*)(wdst + 16384 + j * 4096) = rb[j]; }
        __syncthreads();
        if (k0 + 64 < K) {
#pragma unroll
            for (int j = 0; j < 4; ++j) {
                ra[j] = *(const u32x4*)(ag + (size_t)j * 32 * lda + k0 + 64);
                rb[j] = *(const u32x4*)(bg + (size_t)j * 32 * ldb + k0 + 64);
            }
        }
#pragma unroll
        for (int ks = 0; ks < 2; ++ks) {
            bf16x8 af[4], bf[4];
            const int ko = roff ^ (ks * 64);
#pragma unroll
            for (int i = 0; i < 4; ++i) af[i] = *(const bf16x8*)(ardb + i * 2048 + ko);
#pragma unroll
            for (int j = 0; j < 4; ++j) bf[j] = *(const bf16x8*)(brdb + j * 2048 + ko);
#pragma unroll
            for (int i = 0; i < 4; ++i)
#pragma unroll
                for (int j = 0; j < 4; ++j) {
                    if (SWAP) acc[i][j] = mfma16(bf[j], af[i], acc[i][j]);
                    else acc[i][j] = mfma16(af[i], bf[j], acc[i][j]);
                }
        }
    }
#pragma unroll
    for (int i = 0; i < 4; ++i)
#pragma unroll
        for (int j = 0; j < 4; ++j) {
            if (SWAP) epi.horiz(m0 + wr * 64 + i * 16 + fr, n0 + wc * 64 + j * 16 + fq * 4, acc[i][j]);
            else epi.vert(m0 + wr * 64 + i * 16 + fq * 4, n0 + wc * 64 + j * 16 + fr, acc[i][j]);
        }
}

__device__ __forceinline__ void dft_sym_tile(const bf16_t* __restrict__ Tab, const bf16_t* __restrict__ FTb, bf16_t* __restrict__ MIX,
                                             int b, int m0, int n0, float scale, char* lds) {
    const int tid = get_tid(), lane = tid & 63, wid = tid >> 6, wr = wid >> 1, wc = wid & 1, fr = lane & 15, fq = lane >> 4;
    f32x4 acc[4][4];
    u32x2 cpk[4][4];
#pragma unroll
    for (int i = 0; i < 4; ++i)
#pragma unroll
        for (int j = 0; j < 4; ++j) acc[i][j] = (f32x4){0.f, 0.f, 0.f, 0.f};
    const int lr = tid >> 3, lc = tid & 7;
    const bf16_t* ag = Tab + (size_t)(m0 + lr) * 4096 + lc * 8;
    const bf16_t* bg = FTb + (size_t)(n0 + lr) * 4096 + lc * 8;
    char* wdst = lds + lr * 128 + ((lc ^ ((lr >> 1) & 7)) << 4);
    const int roff = (fq ^ (fr >> 1)) * 16;
    const char* ardb = lds + (wr * 64 + fr) * 128;
    const char* brdb = lds + 16384 + (wc * 64 + fr) * 128;
    u32x4 ra[4], rb[4];
#pragma unroll
    for (int j = 0; j < 4; ++j) { ra[j] = *(const u32x4*)(ag + (size_t)j * 32 * 4096); rb[j] = *(const u32x4*)(bg + (size_t)j * 32 * 4096); }
#pragma unroll 1
    for (int half = 0; half < 2; ++half) {
#pragma unroll 1
        for (int k0 = half * 2048; k0 < half * 2048 + 2048; k0 += 64) {
            __syncthreads();
#pragma unroll
            for (int j = 0; j < 4; ++j) { *(u32x4*)(wdst + j * 4096) = ra[j]; *(u32x4*)(wdst + 16384 + j * 4096) = rb[j]; }
            __syncthreads();
            if (k0 + 64 < 4096) {
#pragma unroll
                for (int j = 0; j < 4; ++j) {
                    ra[j] = *(const u32x4*)(ag + (size_t)j * 32 * 4096 + k0 + 64);
                    rb[j] = *(const u32x4*)(bg + (size_t)j * 32 * 4096 + k0 + 64);
                }
            }
#pragma unroll
            for (int ks = 0; ks < 2; ++ks) {
                bf16x8 af[4], bf[4];
                const int ko = roff ^ (ks * 64);
#pragma unroll
                for (int i = 0; i < 4; ++i) af[i] = *(const bf16x8*)(ardb + i * 2048 + ko);
#pragma unroll
                for (int j = 0; j < 4; ++j) bf[j] = *(const bf16x8*)(brdb + j * 2048 + ko);
#pragma unroll
                for (int i = 0; i < 4; ++i)
#pragma unroll
                    for (int j = 0; j < 4; ++j) acc[i][j] = mfma16(bf[j], af[i], acc[i][j]);
            }
        }
        if (half == 0) {
#pragma unroll
            for (int i = 0; i < 4; ++i)
#pragma unroll
                for (int j = 0; j < 4; ++j) {
                    cpk[i][j][0] = pack2(acc[i][j][0], acc[i][j][1]); cpk[i][j][1] = pack2(acc[i][j][2], acc[i][j][3]);
                    acc[i][j] = (f32x4){0.f, 0.f, 0.f, 0.f};
                }
        }
    }
#pragma unroll
    for (int i = 0; i < 4; ++i)
#pragma unroll
        for (int j = 0; j < 4; ++j) {
            const int m = m0 + wr * 64 + i * 16 + fr, n = n0 + wc * 64 + j * 16 + fq * 4;
            const f32x4 sn = acc[i][j];
            f32x4 c;
            c[0] = bf2f((bf16_t)(cpk[i][j][0] & 0xffffu)); c[1] = bf2f((bf16_t)(cpk[i][j][0] >> 16));
            c[2] = bf2f((bf16_t)(cpk[i][j][1] & 0xffffu)); c[3] = bf2f((bf16_t)(cpk[i][j][1] >> 16));
            u32x2 w0; w0[0] = pack2((c[0] + sn[0]) * scale, (c[1] + sn[1]) * scale); w0[1] = pack2((c[2] + sn[2]) * scale, (c[3] + sn[3]) * scale);
            *(u32x2*)(MIX + (size_t)(b * 2048 + m) * 1024 + 768 + n) = w0;
            if (m > 0) {
                u32x2 w1; w1[0] = pack2((c[0] - sn[0]) * scale, (c[1] - sn[1]) * scale); w1[1] = pack2((c[2] - sn[2]) * scale, (c[3] - sn[3]) * scale);
                *(u32x2*)(MIX + (size_t)(b * 2048 + 2048 - m) * 1024 + 768 + n) = w1;
            }
        }
}
__device__ __forceinline__ void dft_mid_task(const bf16_t* __restrict__ FT, bf16_t* __restrict__ MIX, int q, float scale) {
    const int tid = get_tid(), lane = tid & 63;
    const int b = q >> 2, ch = (q & 3) * 64 + (tid >> 2), part = tid & 3;
    const bf16_t* src = FT + (size_t)b * 256 * 4096 + (size_t)ch * 4096 + part * 512;
    float se = 0.f, so = 0.f;
#pragma unroll 1
    for (int c0 = 0; c0 < 64; c0 += 16) {
        bf16x8 v[16];
#pragma unroll
        for (int i = 0; i < 16; ++i) v[i] = *(const bf16x8*)(src + (c0 + i) * 8);
#pragma unroll
        for (int i = 0; i < 16; ++i)
#pragma unroll
            for (int e = 0; e < 8; e += 2) { se += bfs2f(v[i][e]); so += bfs2f(v[i][e + 1]); }
    }
    float d = se - so;
    d += shx(d, 1, lane);
    d += shx(d, 2, lane);
    if (part == 0) MIX[(size_t)(b * 2048 + 1024) * 1024 + 768 + ch] = f2bf(d * scale);
}

template <bool SWAP, class Epi>
__device__ __forceinline__ void gemm_tile_big(const bf16_t* __restrict__ A, size_t lda, const bf16_t* __restrict__ Bt, size_t ldb,
                                              int K, int m0, int n0, char* lds, const Epi& epi) {
    const int tid = get_tid(), lane = tid & 63, wid = tid >> 6, wr = wid >> 1, wc = wid & 1, fr = lane & 15, fq = lane >> 4;
    f32x4 acc[8][4];
#pragma unroll
    for (int i = 0; i < 8; ++i)
#pragma unroll
        for (int j = 0; j < 4; ++j) acc[i][j] = (f32x4){0.f, 0.f, 0.f, 0.f};
    const int lr = tid >> 2, lc = tid & 3;
    const bf16_t* ag = A + (size_t)(m0 + lr) * lda + lc * 8;
    const bf16_t* bg = Bt + (size_t)(n0 + lr) * ldb + lc * 8;
    char* wdst = lds + lr * 64 + ((lc ^ ((-(lr >> 2)) & 3)) << 4);
    const int roff = (fq ^ ((-(fr >> 2)) & 3)) << 4;
    const char* ardb = lds + (wr * 128 + fr) * 64 + roff;
    const char* brdb = lds + 16384 + (wc * 64 + fr) * 64 + roff;
    u32x4 ra[4], rb[2];
#pragma unroll
    for (int j = 0; j < 4; ++j) ra[j] = *(const u32x4*)(ag + (size_t)j * 64 * lda);
#pragma unroll
    for (int j = 0; j < 2; ++j) rb[j] = *(const u32x4*)(bg + (size_t)j * 64 * ldb);
    for (int k0 = 0; k0 < K; k0 += 32) {
        __syncthreads();
#pragma unroll
        for (int j = 0; j < 4; ++j) *(u32x4*)(wdst + j * 4096) = ra[j];
#pragma unroll
        for (int j = 0; j < 2; ++j) *(u32x4*)(wdst + 16384 + j * 4096) = rb[j];
        __syncthreads();
        if (k0 + 32 < K) {
#pragma unroll
            for (int j = 0; j < 4; ++j) ra[j] = *(const u32x4*)(ag + (size_t)j * 64 * lda + k0 + 32);
#pragma unroll
            for (int j = 0; j < 2; ++j) rb[j] = *(const u32x4*)(bg + (size_t)j * 64 * ldb + k0 + 32);
        }
        bf16x8 bf[4];
#pragma unroll
        for (int j = 0; j < 4; ++j) bf[j] = *(const bf16x8*)(brdb + j * 1024);
#pragma unroll
        for (int i = 0; i < 8; ++i) {
            const bf16x8 af = *(const bf16x8*)(ardb + i * 1024);
#pragma unroll
            for (int j = 0; j < 4; ++j) {
                if (SWAP) acc[i][j] = mfma16(bf[j], af, acc[i][j]);
                else acc[i][j] = mfma16(af, bf[j], acc[i][j]);
            }
        }
    }
#pragma unroll
    for (int i = 0; i < 8; ++i)
#pragma unroll
        for (int j = 0; j < 4; ++j) {
            if (SWAP) epi.horiz(m0 + wr * 128 + i * 16 + fr, n0 + wc * 64 + j * 16 + fq * 4, acc[i][j]);
            else epi.vert(m0 + wr * 128 + i * 16 + fq * 4, n0 + wc * 64 + j * 16 + fr, acc[i][j]);
        }
}

template <bool SWAP, class Epi>
__device__ __forceinline__ void gemm_tile_big64(const bf16_t* __restrict__ A, size_t lda, const bf16_t* __restrict__ Bt, size_t ldb,
                                                int K, int m0, int n0, char* lds, const Epi& epi) {
    const int tid = get_tid(), lane = tid & 63, wid = tid >> 6, wr = wid >> 1, wc = wid & 1, fr = lane & 15, fq = lane >> 4;
    f32x4 acc[8][4];
#pragma unroll
    for (int i = 0; i < 8; ++i)
#pragma unroll
        for (int j = 0; j < 4; ++j) acc[i][j] = (f32x4){0.f, 0.f, 0.f, 0.f};
    const int lr = tid >> 3, lc = tid & 7;
    const bf16_t* ag = A + (size_t)(m0 + lr) * lda + lc * 8;
    const bf16_t* bg = Bt + (size_t)(n0 + lr) * ldb + lc * 8;
    char* wdst = lds + lr * 128 + ((lc ^ ((lr >> 1) & 7)) << 4);
    const int roff = (fq ^ (fr >> 1)) * 16;
    const char* ardb = lds + (wr * 128 + fr) * 128;
    const char* brdb = lds + 32768 + (wc * 64 + fr) * 128;
    u32x4 ra[8], rb[4];
#pragma unroll
    for (int j = 0; j < 8; ++j) ra[j] = *(const u32x4*)(ag + (size_t)j * 32 * lda);
#pragma unroll
    for (int j = 0; j < 4; ++j) rb[j] = *(const u32x4*)(bg + (size_t)j * 32 * ldb);
    for (int k0 = 0; k0 < K; k0 += 64) {
        __syncthreads();
#pragma unroll
        for (int j = 0; j < 8; ++j) *(u32x4*)(wdst + j * 4096) = ra[j];
#pragma unroll
        for (int j = 0; j < 4; ++j) *(u32x4*)(wdst + 32768 + j * 4096) = rb[j];
        __syncthreads();
        if (k0 + 64 < K) {
#pragma unroll
            for (int j = 0; j < 8; ++j) ra[j] = *(const u32x4*)(ag + (size_t)j * 32 * lda + k0 + 64);
#pragma unroll
            for (int j = 0; j < 4; ++j) rb[j] = *(const u32x4*)(bg + (size_t)j * 32 * ldb + k0 + 64);
        }
#pragma unroll
        for (int ks = 0; ks < 2; ++ks) {
            const int ko = roff ^ (ks * 64);
            bf16x8 bf[4];
#pragma unroll
            for (int j = 0; j < 4; ++j) bf[j] = *(const bf16x8*)(brdb + j * 2048 + ko);
#pragma unroll
            for (int i = 0; i < 8; ++i) {
                const bf16x8 af = *(const bf16x8*)(ardb + i * 2048 + ko);
#pragma unroll
                for (int j = 0; j < 4; ++j) {
                    if (SWAP) acc[i][j] = mfma16(bf[j], af, acc[i][j]);
                    else acc[i][j] = mfma16(af, bf[j], acc[i][j]);
                }
            }
        }
    }
#pragma unroll
    for (int i = 0; i < 8; ++i)
#pragma unroll
        for (int j = 0; j < 4; ++j) {
            if (SWAP) epi.horiz(m0 + wr * 128 + i * 16 + fr, n0 + wc * 64 + j * 16 + fq * 4, acc[i][j]);
            else epi.vert(m0 + wr * 128 + i * 16 + fq * 4, n0 + wc * 64 + j * 16 + fr, acc[i][j]);
        }
}

typedef __attribute__((address_space(3))) void* lds_ptr_t;
__device__ __forceinline__ void glds16(const void* g, unsigned lds_base) {
    unsigned sv;
    asm volatile("s_mov_b32 %0, m0\n\ts_mov_b32 m0, %2\n\ts_nop 0\n\tglobal_load_lds_dwordx4 %1, off\n\ts_mov_b32 m0, %0" : "=&s"(sv) : "v"(g), "s"(lds_base) : "memory");
}
template <int MI, bool SWAP, class Epi>
__device__ __forceinline__ void gemm_tile_ring(const bf16_t* __restrict__ A, size_t lda, const bf16_t* __restrict__ Bt, size_t ldb,
                                               int K, int m0, int n0, char* lds, const Epi& epi,
                                               bool prefetched, bool hasNext, int nm0, int nn0) {
    const int tid = get_tid(), lane = tid & 63, wid = __builtin_amdgcn_readfirstlane(tid >> 6), wr = wid >> 1, wc = wid & 1, fr = lane & 15, fq = lane >> 4;
    f32x4 acc[MI][4];
#pragma unroll
    for (int i = 0; i < MI; ++i)
#pragma unroll
        for (int j = 0; j < 4; ++j) acc[i][j] = (f32x4){0.f, 0.f, 0.f, 0.f};
    const int sg = (-(lane >> 4)) & 3, srow = lane >> 2, sc = ((lane & 3) ^ sg) * 8;
    const bf16_t* ag = A + (size_t)(m0 + wid * (MI * 8) + srow) * lda + sc;
    const bf16_t* bg = Bt + (size_t)(n0 + wid * 32 + srow) * ldb + sc;
    const unsigned lbase = (unsigned)(size_t)(lds_ptr_t)lds;
    constexpr int ABYTES = MI * 2048, STAGEB = ABYTES + 8192;
    const unsigned sA = lbase + wid * (MI * 512), sB = lbase + ABYTES + wid * 2048;
    const int roff = (fq ^ ((-(fr >> 2)) & 3)) << 4;
    const char* ardb = lds + (wr * (MI * 16) + fr) * 64 + roff;
    const char* brdb = lds + ABYTES + (wc * 64 + fr) * 64 + roff;
    const int nk = K >> 5;
#define RING_STAGE(st, k0)                                                                                                   \
    {                                                                                                                        \
        const unsigned so_ = (unsigned)(st) * (unsigned)STAGEB;                                                                        \
        _Pragma("unroll") for (int i = 0; i < MI / 2; ++i) glds16((const void*)(ag + (size_t)(i * 16) * lda + (k0)), sA + so_ + i * 1024); \
        _Pragma("unroll") for (int i = 0; i < 2; ++i) glds16((const void*)(bg + (size_t)(i * 16) * ldb + (k0)), sB + so_ + i * 1024); \
    }
    if (!prefetched) {
        __syncthreads();
        RING_STAGE(0, 0);
        RING_STAGE(1, 32);
    }
    int cur = 0;
    for (int kt = 0; kt < nk; ++kt) {
        if (kt + 1 < nk && !(prefetched && kt == 0)) { if (MI == 8) asm volatile("s_waitcnt vmcnt(6)\n\ts_barrier" ::: "memory"); else if (MI == 4) asm volatile("s_waitcnt vmcnt(4)\n\ts_barrier" ::: "memory"); else asm volatile("s_waitcnt vmcnt(3)\n\ts_barrier" ::: "memory"); }
        else asm volatile("s_waitcnt vmcnt(0)\n\ts_barrier" ::: "memory");
        const int so = cur * STAGEB;
        bf16x8 bf[4], af[MI];
#pragma unroll
        for (int j = 0; j < 4; ++j) bf[j] = *(const bf16x8*)(brdb + so + j * 1024);
#pragma unroll
        for (int i = 0; i < MI; ++i) af[i] = *(const bf16x8*)(ardb + so + i * 1024);
        if (kt + 2 < nk) { const int nx = (cur == 0) ? 2 : cur - 1; RING_STAGE(nx, (kt + 2) * 32); }
        if (blockIdx.x & 256) __builtin_amdgcn_s_setprio(2); else __builtin_amdgcn_s_setprio(1);
#pragma unroll
        for (int i = 0; i < MI; ++i) {
#pragma unroll
            for (int j = 0; j < 4; ++j) {
                if (SWAP) acc[i][j] = mfma16(bf[j], af[i], acc[i][j]);
                else acc[i][j] = mfma16(af[i], bf[j], acc[i][j]);
            }
        }
        __builtin_amdgcn_s_setprio(0);
        cur = (cur == 2) ? 0 : cur + 1;
    }
    if (hasNext) {
        __syncthreads();
        ag = A + (size_t)(nm0 + wid * (MI * 8) + srow) * lda + sc;
        bg = Bt + (size_t)(nn0 + wid * 32 + srow) * ldb + sc;
        RING_STAGE(0, 0);
        RING_STAGE(1, 32);
    }
#undef RING_STAGE
    if (SWAP) {
#pragma unroll
        for (int i2 = 0; i2 < MI / 2; ++i2) {
            f32x4 pa[2][4], pg[2][4];
#pragma unroll
            for (int ii = 0; ii < 2; ++ii)
#pragma unroll
                for (int j = 0; j < 4; ++j) epi.pre(m0 + wr * (MI * 16) + (i2 * 2 + ii) * 16 + fr, n0 + wc * 64 + j * 16 + fq * 4, pa[ii][j], pg[ii][j]);
            __builtin_amdgcn_sched_barrier(0);
#pragma unroll
            for (int ii = 0; ii < 2; ++ii)
#pragma unroll
                for (int j = 0; j < 4; ++j) epi.fin(m0 + wr * (MI * 16) + (i2 * 2 + ii) * 16 + fr, n0 + wc * 64 + j * 16 + fq * 4, acc[i2 * 2 + ii][j], pa[ii][j], pg[ii][j]);
        }
    } else {
#pragma unroll
        for (int i = 0; i < MI; ++i)
#pragma unroll
            for (int j = 0; j < 4; ++j) epi.vert(m0 + wr * (MI * 16) + i * 16 + fq * 4, n0 + wc * 64 + j * 16 + fr, acc[i][j]);
    }
}

struct EpiIn {
    bf16_t *P, *VTA, *VTC, *FT; float* G;
    __device__ __forceinline__ void pre(int, int, f32x4&, f32x4&) const {}
    __device__ __forceinline__ void fin(int m, int n, f32x4 v, f32x4, f32x4) const { horiz(m, n, v); }
    __device__ __forceinline__ void horiz(int m, int n, f32x4 v) const {
        if (n < PW) {
            u32x2 w; w.x = pack2(v[0], v[1]); w.y = pack2(v[2], v[3]);
            *(u32x2*)(P + (size_t)m * PW + n) = w;
        } else if (n >= 2816 && n < 2832) {
            *(f32x4*)(G + (size_t)m * 16 + (n - 2816)) = v;
        }
    }
    __device__ __forceinline__ void vert(int m, int n, f32x4 v) const {
        const int which = (n - 1792) >> 8, ch = (n - 1792) & 255;
        SeqInfo s = seqinfo(m);
        u32x2 w; w.x = pack2(v[0], v[1]); w.y = pack2(v[2], v[3]);
        bf16_t* dst;
        if (which == 0) dst = VTA + s.base + (size_t)ch * s.T + s.t;
        else if (which == 1) dst = VTC + s.base + (size_t)ch * s.T + s.t;
        else if (which == 2) dst = FT + 2 * s.base + (size_t)ch * 2 * s.T + s.t;
        else dst = FT + 2 * s.base + (size_t)ch * 2 * s.T + s.T + s.t;
        *(u32x2*)dst = w;
    }
};
struct EpiRes {
    const float *__restrict__ srcLat, *__restrict__ srcCtx; float *__restrict__ dstLat, *__restrict__ dstCtx; const float* __restrict__ mod; int gidx;
    __device__ __forceinline__ void horiz(int m, int n, f32x4 v) const {
        const int b = m < NLAT ? (m >> 11) : 16;
        const f32x4 g = *(const f32x4*)(mod + (size_t)b * 6144 + gidx * 1024 + n);
        const float* __restrict__ s = m < NLAT ? srcLat + (size_t)m * 1024 + n : srcCtx + (size_t)(m - NLAT) * 1024 + n;
        float* __restrict__ d = m < NLAT ? dstLat + (size_t)m * 1024 + n : dstCtx + (size_t)(m - NLAT) * 1024 + n;
        const f32x4 xv = *(const f32x4*)s;
        *(f32x4*)d = xv + g * v;
    }
    __device__ __forceinline__ void pre(int m, int n, f32x4& a, f32x4& g) const {
        const int b = m < NLAT ? (m >> 11) : 16;
        g = *(const f32x4*)(mod + (size_t)b * 6144 + gidx * 1024 + n);
        a = *(const f32x4*)(m < NLAT ? srcLat + (size_t)m * 1024 + n : srcCtx + (size_t)(m - NLAT) * 1024 + n);
    }
    __device__ __forceinline__ void fin(int m, int n, f32x4 v, f32x4 a, f32x4 g) const {
        float* d = m < NLAT ? dstLat + (size_t)m * 1024 + n : dstCtx + (size_t)(m - NLAT) * 1024 + n;
        *(f32x4*)d = a + g * v;
    }
    __device__ __forceinline__ void vert(int, int, f32x4) const {}
};
struct EpiPart {
    float* __restrict__ part; const float* __restrict__ mod; int gidx;
    __device__ __forceinline__ void pre(int, int n, f32x4&, f32x4& g) const { g = *(const f32x4*)(mod + (size_t)16 * 6144 + gidx * 1024 + n); }
    __device__ __forceinline__ void fin(int m, int n, f32x4 v, f32x4, f32x4 g) const { *(f32x4*)(part + (size_t)(m - NLAT) * 1024 + n) = g * v; }
    __device__ __forceinline__ void horiz(int, int, f32x4) const {}
    __device__ __forceinline__ void vert(int, int, f32x4) const {}
};
struct EpiFF1 {
    bf16_t* HID;
    __device__ __forceinline__ void pre(int, int, f32x4&, f32x4&) const {}
    __device__ __forceinline__ void fin(int m, int n, f32x4 v, f32x4, f32x4) const { horiz(m, n, v); }
    __device__ __forceinline__ void horiz(int m, int n, f32x4 v) const {
        float a = fmaxf(v[0], 0.f), b = fmaxf(v[1], 0.f), c = fmaxf(v[2], 0.f), d = fmaxf(v[3], 0.f);
        u32x2 w; w.x = pack2(a * a, b * b); w.y = pack2(c * c, d * d);
        *(u32x2*)(HID + (size_t)m * DFF + n) = w;
    }
    __device__ __forceinline__ void vert(int, int, f32x4) const {}
};
struct EpiDFT {
    bf16_t* MIX; int tok0; float scale;
    __device__ __forceinline__ void horiz(int m, int n, f32x4 v) const {
        u32x2 w; w.x = pack2(v[0] * scale, v[1] * scale); w.y = pack2(v[2] * scale, v[3] * scale);
        *(u32x2*)(MIX + (size_t)(tok0 + m) * 1024 + 768 + n) = w;
    }
    __device__ __forceinline__ void vert(int, int, f32x4) const {}
};

__device__ __forceinline__ void tconv_tile(const float* __restrict__ src, int ld_src, int nvalid, bf16_t* __restrict__ dst, int ld_dst,
                           int k0, int ns0, int nd0, float* t) {
    const int tid = get_tid();
    __syncthreads();
    {
        const int n = tid & 63;
        const bool ok = (ns0 + n < nvalid);
        const int nc = ok ? (ns0 + n) : 0;
        float vv[16];
#pragma unroll
        for (int i = 0; i < 16; ++i) vv[i] = src[(size_t)(k0 + i * 4 + (tid >> 6)) * ld_src + nc];
#pragma unroll
        for (int i = 0; i < 16; ++i) t[(i * 4 + (tid >> 6)) * 65 + n] = ok ? vv[i] : 0.f;
    }
    __syncthreads();
#pragma unroll 4
    for (int i = 0; i < 16; ++i) {
        int n = i * 4 + (tid >> 6), k = tid & 63;
        dst[(size_t)(nd0 + n) * ld_dst + k0 + k] = f2bf(t[k * 65 + n]);
    }
}
__device__ __forceinline__ void fold_dft_tile(const float* __restrict__ w_in_l, bf16_t* __restrict__ WinT_l, int kb, int g, float* t) {
    const int tid = get_tid();
    float* cs = t + 64 * 65;
    __syncthreads();
    if (tid < 64) { cs[tid] = cospif((float)tid / 32.f); cs[64 + tid] = sinpif((float)tid / 32.f); }
    for (int i = 0; i < 16; ++i) {
        int k = i * 4 + (tid >> 6), c = tid & 63;
        t[k * 65 + c] = w_in_l[(size_t)(kb * 64 + k) * DIN + 2304 + g * 64 + c];
    }
    __syncthreads();
    const int k = tid & 63, cg0 = (tid >> 6) * 16;
    for (int cc = 0; cc < 16; ++cc) {
        const int cp = cg0 + cc;
        float sc = 0.f, ss = 0.f;
        for (int c = 0; c < 64; ++c) {
            float v = t[k * 65 + c];
            int idx = (c * cp) & 63;
            sc += v * cs[idx]; ss += v * cs[64 + idx];
        }
        WinT_l[(size_t)(2304 + g * 64 + cp) * 1024 + kb * 64 + k] = f2bf(sc);
        WinT_l[(size_t)(2560 + g * 64 + cp) * 1024 + kb * 64 + k] = f2bf(ss);
    }
}
__device__ __forceinline__ void mod_task(const Params& p, int l, int cb, float* red) {
    const int tid = get_tid(), cl = tid & 63, ks = tid >> 6, col = cb * 64 + cl;
    float acc[17];
#pragma unroll
    for (int r = 0; r < 17; ++r) acc[r] = 0.f;
    const float* W = p.w_ada + (size_t)l * 1024 * 6144;
    float* sl = red + 4352 + ks * 1088;
    for (int kc = 0; kc < 4; ++kc) {
        const int kb = ks * 256 + kc * 64;
        __syncthreads();
#pragma unroll
        for (int r = 0; r < 17; ++r) {
            const float cv = (r < 16) ? p.c[r * 1024 + kb + cl] : p.c_ctx[kb + cl];
            sl[r * 64 + cl] = cv * __builtin_amdgcn_rcpf(1.f + __expf(-cv));
        }
        __syncthreads();
#pragma unroll 1
        for (int k32 = 0; k32 < 64; k32 += 32) {
            float wv_[32];
#pragma unroll
            for (int kk = 0; kk < 32; ++kk) wv_[kk] = W[(size_t)(kb + k32 + kk) * 6144 + col];
#pragma unroll
            for (int kk = 0; kk < 32; ++kk)
#pragma unroll
                for (int r = 0; r < 17; ++r) acc[r] += sl[r * 64 + k32 + kk] * wv_[kk];
        }
    }
    __syncthreads();
#pragma unroll
    for (int r = 0; r < 17; ++r) red[(ks * 17 + r) * 64 + cl] = acc[r];
    __syncthreads();
    float* modall = (float*)(p.ws + OFF_MOD);
    for (int idx = tid; idx < 17 * 64; idx += NTHREADS) {
        int r = idx >> 6, c = idx & 63;
        float s = red[(0 * 17 + r) * 64 + c] + red[(1 * 17 + r) * 64 + c] + red[(2 * 17 + r) * 64 + c] + red[(3 * 17 + r) * 64 + c];
        modall[(size_t)(l * 17 + r) * 6144 + cb * 64 + c] = s + p.b_ada[l * 6144 + cb * 64 + c];
    }
}

__device__ __forceinline__ void prologue_phase(const Params& p, char* lds) {
    float* t = (float*)lds;
    bf16_t* WinT = (bf16_t*)(p.ws + OFF_WIN);
    bf16_t* WoutT = (bf16_t*)(p.ws + OFF_WOUT);
    bf16_t* W1T = (bf16_t*)(p.ws + OFF_W1);
    bf16_t* W2T = (bf16_t*)(p.ws + OFF_W2);
    bf16_t* Wsb = (bf16_t*)(p.ws + OFF_WSP);
    bf16_t* TabL = (bf16_t*)(p.ws + OFF_TABL);
    bf16_t* TabC = (bf16_t*)(p.ws + OFF_TABC);
    const int tid = get_tid();
    constexpr int N_WIN = 2 * 38 * 16;
    constexpr int N_WOUT = 2 * 16 * 12;
    constexpr int N_W1 = 2 * 64 * 16;
    constexpr int N_W2 = 2 * 16 * 64;
    constexpr int N_FOLD = 2 * 16 * 4;
    constexpr int N_WFO = 2 * 32 * 4;
    constexpr int N_WSP = 128;
    constexpr int N_TABL = 1024;
    constexpr int N_TABC = 128;
    constexpr int N_MOD = 2 * 96;
    constexpr int B1 = N_WIN, B2 = B1 + N_WOUT, B3 = B2 + N_W1, B4 = B3 + N_W2, B5 = B4 + N_FOLD, B6 = B5 + N_WFO,
                  B7 = B6 + N_WSP, B8 = B7 + N_TABL, B9 = B8 + N_TABC, B10 = B9 + N_MOD;
    for (int task = blockIdx.x; task < B10; task += gridDim.x) {
        if (task < B1) {
            int l = task / (38 * 16), r = task % (38 * 16), nb = r / 16, kb = r % 16;
            int nd0 = nb * 64, ns0 = 0, nvalid = DIN;
            if (nb < 8) ns0 = nd0;
            else if (nb < 16) ns0 = 768 + (nd0 - 512);
            else if (nb < 24) ns0 = 1280 + (nd0 - 1024);
            else if (nb < 28) ns0 = 2048 + (nd0 - 1536);
            else if (nb < 32) ns0 = 512 + (nd0 - 1792);
            else if (nb < 36) ns0 = 1792 + (nd0 - 2048);
            else if (nb == 36) { nd0 = 2816; ns0 = 2560; }
            else { nd0 = 2880; ns0 = 0; nvalid = 0; }
            tconv_tile(p.w_in + (size_t)l * 1024 * DIN, DIN, nvalid, WinT + (size_t)l * NPAD * 1024, 1024, kb * 64, ns0, nd0, t);
        } else if (task < B2) {
            int q = task - B1, l = q / 192, r = q % 192, nb = r / 12, kb = r % 12;
            tconv_tile(p.w_out + (size_t)l * 1024 * 1024, 1024, 1024, WoutT + (size_t)l * 1024 * 1024, 1024, kb * 64, nb * 64, nb * 64, t);
        } else if (task < B3) {
            int q = task - B2, l = q / 1024, r = q % 1024, nb = r / 16, kb = r % 16;
            tconv_tile(p.w_ff1 + (size_t)l * 1024 * 4096, 4096, 4096, W1T + (size_t)l * 4096 * 1024, 1024, kb * 64, nb * 64, nb * 64, t);
        } else if (task < B4) {
            int q = task - B3, l = q / 1024, r = q % 1024, nb = r / 64, kb = r % 64;
            tconv_tile(p.w_ff2 + (size_t)l * 4096 * 1024, 1024, 1024, W2T + (size_t)l * 1024 * 4096, 4096, kb * 64, nb * 64, nb * 64, t);
        } else if (task < B5) {
            int q = task - B4, l = q / 64, r = q % 64, kb = r / 4, g = r % 4;
            fold_dft_tile(p.w_in + (size_t)l * 1024 * DIN, WinT + (size_t)l * NPAD * 1024, kb, g, t);
        } else if (task < B6) {
            const int q = task - B5, l = q / 128, r = q % 128, i0 = (r >> 2) * 8, n = (r & 3) * 256 + tid;
            const float* __restrict__ wf = p.w_fnet + (size_t)l * 256 * 256 + (size_t)i0 * 256;
            const float* __restrict__ wo = p.w_out + (size_t)l * 1024 * 1024 + (size_t)768 * 1024 + n;
            float a8[8];
#pragma unroll
            for (int ii = 0; ii < 8; ++ii) a8[ii] = 0.f;
#pragma unroll 1
            for (int j0 = 0; j0 < 256; j0 += 32) {
                float wv_[32];
#pragma unroll
                for (int jj = 0; jj < 32; ++jj) wv_[jj] = wo[(size_t)(j0 + jj) * 1024];
#pragma unroll
                for (int jj = 0; jj < 32; ++jj)
#pragma unroll
                    for (int ii = 0; ii < 8; ++ii) a8[ii] += wf[ii * 256 + j0 + jj] * wv_[jj];
            }
            u32x4 o4;
            o4[0] = pack2(a8[0], a8[1]); o4[1] = pack2(a8[2], a8[3]); o4[2] = pack2(a8[4], a8[5]); o4[3] = pack2(a8[6], a8[7]);
            *(u32x4*)(WoutT + (size_t)l * 1024 * 1024 + (size_t)n * 1024 + 768 + i0) = o4;
        } else if (task < B7) {
            int q = task - B6;
            for (int e = 0; e < 4; ++e) { int idx = q * 1024 + e * 256 + tid; Wsb[idx] = f2bf(p.w_sp[idx]); }
        } else if (task < B8) {
            int tp = task - B7;
            for (int e = 0; e < 16; ++e) {
                int k = e * 256 + tid;
                int tt = k & 2047;
                int idx = (tt * tp) & 2047;
                float ang = (float)idx / 1024.f;
                float v = (k < 2048) ? cospif(ang) : -sinpif(ang);
                TabL[(size_t)tp * 4096 + k] = f2bf(v);
            }
        } else if (task < B9) {
            int q = task - B8;
            for (int e = 0; e < 4; ++e) {
                int id = q * 1024 + e * 256 + tid;
                int tp = id >> 9, k = id & 511, tt = k & 255;
                int idx = (tt * tp) & 255;
                float ang = (float)idx / 128.f;
                float v = (k < 256) ? cospif(ang) : -sinpif(ang);
                TabC[id] = f2bf(v);
            }
        } else {
            int q = task - B9, l = q / 96, cb = q % 96;
            mod_task(p, l, cb, t);
        }
    }
}

__device__ __forceinline__ void norm_phase(const Params& p, int l, const float* srcLat, const float* srcCtx, const float* g, int shiftIdx, int scaleIdx, int M, const float* ctxExtra = nullptr) {
    const int tid = get_tid(), lane = tid & 63;
    const int wave = blockIdx.x * 4 + (tid >> 6), nw = gridDim.x * 4;
    const float* modall = (const float*)(p.ws + OFF_MOD);
    bf16_t* H = (bf16_t*)(p.ws + OFF_HM);
    for (int row0 = wave; row0 < M; row0 += 2 * nw) {
        const bool has1 = (row0 + nw) < M;
        int rows[2]; rows[0] = row0; rows[1] = has1 ? row0 + nw : row0;
        f32x4 v[2][4], gv[4], scv[2][4], shv[2][4];
#pragma unroll
        for (int rI = 0; rI < 2; ++rI) {
            const int row = rows[rI];
            const float* xr = row < NLAT ? srcLat + (size_t)row * 1024 : srcCtx + (size_t)(row - NLAT) * 1024;
            const int b = row < NLAT ? (row >> 11) : 16;
            const float* mod = modall + (size_t)(l * 17 + b) * 6144;
#pragma unroll
            for (int i = 0; i < 4; ++i) {
                const int col = i * 256 + lane * 4;
                v[rI][i] = *(const f32x4*)(xr + col);
                if (ctxExtra != nullptr && row >= NLAT) v[rI][i] += *(const f32x4*)(ctxExtra + (size_t)(row - NLAT) * 1024 + col);
                scv[rI][i] = *(const f32x4*)(mod + scaleIdx * 1024 + col);
                shv[rI][i] = *(const f32x4*)(mod + shiftIdx * 1024 + col);
            }
        }
#pragma unroll
        for (int i = 0; i < 4; ++i) gv[i] = *(const f32x4*)(g + i * 256 + lane * 4);
        __builtin_amdgcn_sched_barrier(0);
#pragma unroll
        for (int rI = 0; rI < 2; ++rI) {
            float ss = 0.f;
#pragma unroll
            for (int i = 0; i < 4; ++i) ss += v[rI][i][0] * v[rI][i][0] + v[rI][i][1] * v[rI][i][1] + v[rI][i][2] * v[rI][i][2] + v[rI][i][3] * v[rI][i][3];
#pragma unroll
            for (int o = 32; o >= 1; o >>= 1) ss += shx(ss, o, lane);
            const float rstd = rsqrtf(ss * (1.f / 1024.f) + 1e-6f);
            if (rI == 0 || has1) {
#pragma unroll
                for (int i = 0; i < 4; ++i) {
                    const int col = i * 256 + lane * 4;
                    f32x4 y = v[rI][i] * rstd * gv[i] * (scv[rI][i] + 1.f) + shv[rI][i];
                    u32x2 w; w.x = pack2(y[0], y[1]); w.y = pack2(y[2], y[3]);
                    *(u32x2*)(H + (size_t)rows[rI] * 1024 + col) = w;
                }
            }
        }
    }
}
__device__ __forceinline__ void final_norm_phase(const Params& p) {
    const int tid = get_tid(), lane = tid & 63;
    const int wave = blockIdx.x * 4 + (tid >> 6), nw = gridDim.x * 4;
    for (int row = wave; row < NLAT; row += nw) {
        float* xr = p.out + (size_t)row * 1024;
        f32x4 v[4], gfv[4];
        float ss = 0.f;
#pragma unroll
        for (int i = 0; i < 4; ++i) { v[i] = *(const f32x4*)(xr + i * 256 + lane * 4); gfv[i] = *(const f32x4*)(p.g_final + i * 256 + lane * 4); }
        __builtin_amdgcn_sched_barrier(0);
#pragma unroll
        for (int i = 0; i < 4; ++i) ss += v[i][0] * v[i][0] + v[i][1] * v[i][1] + v[i][2] * v[i][2] + v[i][3] * v[i][3];
#pragma unroll
        for (int o = 32; o >= 1; o >>= 1) ss += shx(ss, o, lane);
        const float rstd = rsqrtf(ss * (1.f / 1024.f) + 1e-6f);
#pragma unroll
        for (int i = 0; i < 4; ++i) {
            const int col = i * 256 + lane * 4;
            const f32x4 gg = gfv[i];
            *(f32x4*)(xr + col) = v[i] * rstd * gg;
        }
    }
}

__device__ __forceinline__ void attn_chunk(f32x4 (&st)[16], float& m_run, float& sum, f32x4 (&o)[4], const bf16_t* vbase,
                                           int pairStride, size_t ndStride, int fq, int lane) {
    bf16x8 vb0[4][4];
#pragma unroll
    for (int i = 0; i < 4; ++i)
#pragma unroll
        for (int nd = 0; nd < 4; ++nd) {
            const bf16_t* vp = vbase + nd * ndStride + i * pairStride;
            vb0[i][nd] = cat4(*(const bf16x4*)vp, *(const bf16x4*)(vp + 16));
        }
    __builtin_amdgcn_sched_barrier(0);
    float mx = m_run;
#pragma unroll
    for (int i = 0; i < 16; ++i) mx = fmaxf(mx, fmaxf(fmaxf(st[i][0], st[i][1]), fmaxf(st[i][2], st[i][3])));
    mx = fmaxf(mx, shx(mx, 16, lane));
    mx = fmaxf(mx, shx(mx, 32, lane));
    const float scale = __expf(m_run - mx);
    float cs = 0.f;
#pragma unroll
    for (int i = 0; i < 16; ++i)
#pragma unroll
        for (int j = 0; j < 4; ++j) { float e = __expf(st[i][j] - mx); st[i][j] = e; cs += e; }
    cs += shx(cs, 16, lane);
    cs += shx(cs, 32, lane);
    sum = sum * scale + cs;
    m_run = mx;
#pragma unroll
    for (int j = 0; j < 4; ++j) {
        const float sq = shi(scale, fq * 4 + j);
#pragma unroll
        for (int nd = 0; nd < 4; ++nd) o[nd][j] *= sq;
    }
    bf16x8 vb1[4][4];
#pragma unroll
    for (int i = 0; i < 4; ++i)
#pragma unroll
        for (int nd = 0; nd < 4; ++nd) {
            const bf16_t* vp = vbase + nd * ndStride + (i + 4) * pairStride;
            vb1[i][nd] = cat4(*(const bf16x4*)vp, *(const bf16x4*)(vp + 16));
        }
    __builtin_amdgcn_sched_barrier(0);
#pragma unroll
    for (int i = 0; i < 4; ++i) {
        const bf16x8 pa = packw(st[2 * i], st[2 * i + 1]);
#pragma unroll
        for (int nd = 0; nd < 4; ++nd) o[nd] = mfma16(pa, vb0[i][nd], o[nd]);
    }
#pragma unroll
    for (int i = 0; i < 4; ++i) {
        const bf16x8 pa = packw(st[2 * i + 8], st[2 * i + 9]);
#pragma unroll
        for (int nd = 0; nd < 4; ++nd) o[nd] = mfma16(pa, vb1[i][nd], o[nd]);
    }
}

template <bool CTXQ>
__device__ __forceinline__ void attn_unit(const Params& p, int l, int u, char* lds) {
    const bf16_t* __restrict__ P = (const bf16_t*)(p.ws + OFF_P);
    const bf16_t* VTA = (const bf16_t*)(p.ws + OFF_VTA);
    bf16_t* __restrict__ MIX = (bf16_t*)(p.ws + OFF_HM);
    float* rp = (float*)lds;
    const int tid = get_tid(), lane = tid & 63, w = tid >> 6, fr = lane & 15, fq = lane >> 4;
    int b, h, r = 0, qb = 0;
    if (CTXQ) { b = u >> 4; h = (u >> 2) & 3; qb = u & 3; }
    else { b = u >> 7; h = (u >> 5) & 3; r = u & 31; }
    if (!CTXQ) {
        __syncthreads();
        for (int i = tid; i < 465; i += NTHREADS) rp[i] = p.rpb[(size_t)(l * 4 + h) * 465 + i];
        __syncthreads();
    }
    const int tq0 = CTXQ ? NLAT + b * 256 + qb * 64 + w * 16 : b * 2048 + r * 64 + w * 16;
    const bf16_t* qp = P + (size_t)(tq0 + fr) * PW + h * 64 + fq * 8;
    const bf16x8 bq0 = *(const bf16x8*)qp, bq1 = *(const bf16x8*)(qp + 32);
    float m_run = -3e38f, sum = 0.f;
    f32x4 o[4];
#pragma unroll
    for (int nd = 0; nd < 4; ++nd) o[nd] = (f32x4){0.f, 0.f, 0.f, 0.f};
    f32x4 st[16];
    if (!CTXQ) {
        const int rs = min(max(r - 4, 0), 24), ks0 = min(max(w * 16 - 8, 0), 32);
        const int c = w * 16 + fr, qs = min(max(c - 8, 0), 48);
#pragma unroll
        for (int bt = 0; bt < 2; ++bt) {
            bf16x8 ka[8][2];
#pragma unroll
            for (int t8 = 0; t8 < 8; ++t8) {
                const int rr = bt * 4 + (t8 >> 1), ct = t8 & 1;
                const int tokk = b * 2048 + (rs + rr) * 64 + ks0 + ct * 16 + fr;
                const bf16_t* kp = P + (size_t)tokk * PW + 256 + h * 64 + fq * 8;
                ka[t8][0] = *(const bf16x8*)kp; ka[t8][1] = *(const bf16x8*)(kp + 32);
            }
            __builtin_amdgcn_sched_barrier(0);
#pragma unroll
            for (int t8 = 0; t8 < 8; ++t8) {
                const int rr = bt * 4 + (t8 >> 1), ct = t8 & 1;
                f32x4 acc = (f32x4){0.f, 0.f, 0.f, 0.f};
                acc = mfma16(ka[t8][0], bq0, acc);
                acc = mfma16(ka[t8][1], bq1, acc);
#pragma unroll
                for (int j = 0; j < 4; ++j) {
                    const int kc = ks0 + ct * 16 + fq * 4 + j;
                    const bool valid = (kc >= qs) && (kc < qs + 16);
                    const int bi = valid ? (rs + rr - r + 7) * 31 + (kc - c + 15) : 0;
                    const float bias = rp[bi];
                    st[rr * 2 + ct][j] = valid ? acc[j] * 0.125f + bias : -1e30f;
                }
            }
        }
        const bf16_t* vbase = VTA + (size_t)b * 256 * 2048 + (size_t)(h * 64 + fr) * 2048 + rs * 64 + ks0 + 4 * fq;
        attn_chunk(st, m_run, sum, o, vbase, 64, (size_t)16 * 2048, fq, lane);
    }
#pragma unroll
    for (int bt = 0; bt < 2; ++bt) {
        bf16x8 ka[8][2];
#pragma unroll
        for (int t8 = 0; t8 < 8; ++t8) {
            const int tokk = NLAT + b * 256 + (bt * 8 + t8) * 16 + fr;
            const bf16_t* kp = P + (size_t)tokk * PW + 256 + h * 64 + fq * 8;
            ka[t8][0] = *(const bf16x8*)kp; ka[t8][1] = *(const bf16x8*)(kp + 32);
        }
        __builtin_amdgcn_sched_barrier(0);
#pragma unroll
        for (int t8 = 0; t8 < 8; ++t8) {
            f32x4 acc = (f32x4){0.f, 0.f, 0.f, 0.f};
            acc = mfma16(ka[t8][0], bq0, acc);
            acc = mfma16(ka[t8][1], bq1, acc);
            st[bt * 8 + t8] = acc * 0.125f;
        }
    }
    {
        const bf16_t* vbase = VTA + (size_t)NLAT * 256 + (size_t)b * 256 * 256 + (size_t)(h * 64 + fr) * 256 + 4 * fq;
        attn_chunk(st, m_run, sum, o, vbase, 32, (size_t)16 * 256, fq, lane);
    }
#pragma unroll
    for (int j = 0; j < 4; ++j) {
        const int q = fq * 4 + j;
        const float inv = __builtin_amdgcn_rcpf(shi(sum, q));
#pragma unroll
        for (int nd = 0; nd < 4; ++nd) MIX[(size_t)(tq0 + q) * 1024 + h * 64 + nd * 16 + fr] = f2bf(o[nd][j] * inv);
    }
}

__device__ __forceinline__ void attn_softmax(f32x4 (&st)[16], float& m_run, float& sum, f32x4 (&o)[4], int fq, int lane) {
    float mx = m_run;
#pragma unroll
    for (int i = 0; i < 16; ++i) mx = fmaxf(mx, fmaxf(fmaxf(st[i][0], st[i][1]), fmaxf(st[i][2], st[i][3])));
    mx = fmaxf(mx, shx(mx, 16, lane));
    mx = fmaxf(mx, shx(mx, 32, lane));
    const float scale = __expf(m_run - mx);
    float cs = 0.f;
#pragma unroll
    for (int i = 0; i < 16; ++i)
#pragma unroll
        for (int j = 0; j < 4; ++j) { float e = __expf(st[i][j] - mx); st[i][j] = e; cs += e; }
    cs += shx(cs, 16, lane);
    cs += shx(cs, 32, lane);
    sum = sum * scale + cs;
    m_run = mx;
#pragma unroll
    for (int j = 0; j < 4; ++j) {
        const float sq = shi(scale, fq * 4 + j);
#pragma unroll
        for (int nd = 0; nd < 4; ++nd) o[nd][j] *= sq;
    }
}
__device__ __forceinline__ void attn_pv(const f32x4 (&st)[16], f32x4 (&o)[4], const char* vt, int rowB, int tl0, int pairTok, int fr, int fq) {
#pragma unroll
    for (int i = 0; i < 8; ++i) {
        const bf16x8 pa = packw(st[2 * i], st[2 * i + 1]);
        const int tl = tl0 + i * pairTok + 4 * fq, tl2 = tl + 16;
#pragma unroll
        for (int nd = 0; nd < 4; ++nd) {
            const int d = nd * 16 + fr;
            const char* row = vt + d * rowB;
            const bf16x4 v0 = *(const bf16x4*)(row + (((tl >> 3) ^ (d & 15)) << 4) + (tl & 7) * 2);
            const bf16x4 v1 = *(const bf16x4*)(row + (((tl2 >> 3) ^ (d & 15)) << 4) + (tl2 & 7) * 2);
            o[nd] = mfma16(pa, cat4(v0, v1), o[nd]);
        }
    }
}
template <bool CTXQ>
__device__ __forceinline__ void attn_unit2(const Params& p, int l, int u, char* lds) {
    const bf16_t* __restrict__ P = (const bf16_t*)(p.ws + OFF_P);
    const bf16_t* __restrict__ VTA = (const bf16_t*)(p.ws + OFF_VTA);
    bf16_t* __restrict__ MIX = (bf16_t*)(p.ws + OFF_HM);
    float* rp = (float*)lds;
    char* sg = lds + 2048;
    const unsigned lb = (unsigned)(size_t)(lds_ptr_t)lds + 2048u;
    const int tid = get_tid(), lane = tid & 63, w = __builtin_amdgcn_readfirstlane(tid >> 6), fr = lane & 15, fq = lane >> 4;
    int b, h, r = 0, qb = 0;
    if (CTXQ) { b = u >> 4; h = (u >> 2) & 3; qb = u & 3; }
    else { b = u >> 7; h = (u >> 5) & 3; r = u & 31; }
    __syncthreads();
    if (!CTXQ) { for (int i = tid; i < 465; i += NTHREADS) rp[i] = p.rpb[(size_t)(l * 4 + h) * 465 + i]; }
    const int tq0 = CTXQ ? NLAT + b * 256 + qb * 64 + w * 16 : b * 2048 + r * 64 + w * 16;
    const bf16_t* qp = P + (size_t)(tq0 + fr) * PW + h * 64 + fq * 8;
    const bf16x8 bq0 = *(const bf16x8*)qp, bq1 = *(const bf16x8*)(qp + 32);
    float m_run = -3e38f, sum = 0.f;
    f32x4 o[4];
#pragma unroll
    for (int nd = 0; nd < 4; ++nd) o[nd] = (f32x4){0.f, 0.f, 0.f, 0.f};
    f32x4 st[16];
    const int ksw = lane >> 4, kch = lane & 7, krow = lane >> 3;
    if (!CTXQ) {
        const int rs = min(max(r - 4, 0), 24), ks0 = min(max(w * 16 - 8, 0), 32);
        const int c = w * 16 + fr, qs = min(max(c - 8, 0), 48);
        const int tokb = b * 2048 + rs * 64;
#pragma unroll
        for (int i = 0; i < 16; ++i) {
            const int pc = w * 16 + i;
            const int sc = kch ^ (((pc & 1) * 4 + ksw) & 7);
            glds16((const void*)(P + (size_t)(tokb + pc * 8 + krow) * PW + 256 + h * 64 + sc * 8), lb + pc * 1024);
        }
        asm volatile("s_waitcnt vmcnt(0)" ::: "memory");
        __syncthreads();
#pragma unroll
        for (int rr = 0; rr < 8; ++rr)
#pragma unroll
            for (int ct = 0; ct < 2; ++ct) {
                const int tokidx = rr * 64 + ks0 + ct * 16 + fr, sw = (tokidx >> 1) & 7;
                const bf16x8 ka0 = *(const bf16x8*)(sg + tokidx * 128 + ((fq ^ sw) << 4));
                const bf16x8 ka1 = *(const bf16x8*)(sg + tokidx * 128 + (((4 + fq) ^ sw) << 4));
                f32x4 acc = (f32x4){0.f, 0.f, 0.f, 0.f};
                acc = mfma16(ka0, bq0, acc);
                acc = mfma16(ka1, bq1, acc);
#pragma unroll
                for (int j = 0; j < 4; ++j) {
                    const int kc = ks0 + ct * 16 + fq * 4 + j;
                    const bool valid = (kc >= qs) && (kc < qs + 16);
                    const int bi = valid ? (rs + rr - r + 7) * 31 + (kc - c + 15) : 0;
                    const float bias = rp[bi];
                    st[rr * 2 + ct][j] = valid ? acc[j] * 0.125f + bias : -1e30f;
                }
            }
        __syncthreads();
#pragma unroll
        for (int i = 0; i < 16; ++i) {
            const int d = w * 16 + i;
            glds16((const void*)(VTA + (size_t)b * 256 * 2048 + (size_t)(h * 64 + d) * 2048 + rs * 64 + ((lane ^ (d & 15)) << 3)), lb + d * 1024);
        }
        attn_softmax(st, m_run, sum, o, fq, lane);
        asm volatile("s_waitcnt vmcnt(0)" ::: "memory");
        __syncthreads();
        attn_pv(st, o, sg, 1024, ks0, 64, fr, fq);
        __syncthreads();
    }
#pragma unroll
    for (int i = 0; i < 8; ++i) {
        const int pc = w * 8 + i;
        const int sc = kch ^ (((pc & 1) * 4 + ksw) & 7);
        glds16((const void*)(P + (size_t)(NLAT + b * 256 + pc * 8 + krow) * PW + 256 + h * 64 + sc * 8), lb + pc * 1024);
    }
#pragma unroll
    for (int i = 0; i < 8; ++i) {
        const int jj = w * 8 + i;
        const int d = 2 * jj + (lane >> 5), cp = lane & 31;
        glds16((const void*)(VTA + (size_t)NLAT * 256 + (size_t)b * 256 * 256 + (size_t)(h * 64 + d) * 256 + ((cp ^ (d & 15)) << 3)), lb + 32768 + jj * 1024);
    }
    asm volatile("s_waitcnt vmcnt(0)" ::: "memory");
    __syncthreads();
#pragma unroll
    for (int ct = 0; ct < 16; ++ct) {
        const int tokidx = ct * 16 + fr, sw = (tokidx >> 1) & 7;
        const bf16x8 ka0 = *(const bf16x8*)(sg + tokidx * 128 + ((fq ^ sw) << 4));
        const bf16x8 ka1 = *(const bf16x8*)(sg + tokidx * 128 + (((4 + fq) ^ sw) << 4));
        f32x4 acc = (f32x4){0.f, 0.f, 0.f, 0.f};
        acc = mfma16(ka0, bq0, acc);
        acc = mfma16(ka1, bq1, acc);
        st[ct] = acc * 0.125f;
    }
    attn_softmax(st, m_run, sum, o, fq, lane);
    attn_pv(st, o, sg + 32768, 512, 0, 32, fr, fq);
#pragma unroll
    for (int j = 0; j < 4; ++j) {
        const int q = fq * 4 + j;
        const float inv = __builtin_amdgcn_rcpf(shi(sum, q));
#pragma unroll
        for (int nd = 0; nd < 4; ++nd) MIX[(size_t)(tq0 + q) * 1024 + h * 64 + nd * 16 + fr] = f2bf(o[nd][j] * inv);
    }
}

__device__ __forceinline__ void gmlp_unit(const Params& p, int l, int u, char* lds) {
    const bf16_t* __restrict__ P = (const bf16_t*)(p.ws + OFF_P);
    const bf16_t* Wsb = (const bf16_t*)(p.ws + OFF_WSP);
    bf16_t* __restrict__ MIX = (bf16_t*)(p.ws + OFF_HM);
    float* rs = (float*)lds;
    bf16_t* zT = (bf16_t*)(lds + 512);
    const int tid = get_tid(), lane = tid & 63, w = tid >> 6, fr = lane & 15, fq = lane >> 4;
    int tok0;
    if (u < 256) tok0 = (u >> 4) * 2048 + (u & 15) * 128;
    else { int j = u - 256; tok0 = NLAT + (j >> 1) * 256 + (j & 1) * 128; }
    __syncthreads();
    {
        const int q = tid >> 1, hf = tid & 1;
        const bf16_t* zp = P + (size_t)(tok0 + q) * PW + 768 + hf * 128;
        float ss = 0.f;
#pragma unroll
        for (int i = 0; i < 16; ++i) {
            const bf16x8 v = *(const bf16x8*)(zp + i * 8);
#pragma unroll
            for (int e = 0; e < 8; ++e) { float z = gelu_tanh(bfs2f(v[e])); ss += z * z; }
        }
        ss += shx(ss, 1, lane);
        if (!hf) rs[q] = rsqrtf(ss * (1.f / 256.f) + 1e-6f);
    }
    for (int h = 0; h < 4; ++h) {
        bf16x8 afr[4][2];
        __syncthreads();
        {
            const int q = tid & 127, dh = tid >> 7;
            const bf16_t* zp = P + (size_t)(tok0 + q) * PW + 768 + h * 64 + dh * 32;
            const float r = rs[q];
            bf16x8 zv[4];
#pragma unroll
            for (int i4 = 0; i4 < 4; ++i4) zv[i4] = *(const bf16x8*)(zp + i4 * 8);
#pragma unroll
            for (int ks = 0; ks < 4; ++ks)
#pragma unroll
                for (int i = 0; i < 2; ++i) afr[ks][i] = *(const bf16x8*)(Wsb + (size_t)((l * 4 + h) * 128 + w * 32 + i * 16 + fr) * 128 + ks * 32 + fq * 8);
            __builtin_amdgcn_sched_barrier(0);
#pragma unroll
            for (int i4 = 0; i4 < 4; ++i4) {
                const bf16x8 v = zv[i4];
#pragma unroll
                for (int e = 0; e < 8; ++e) {
                    const int d = dh * 32 + i4 * 8 + e;
                    zT[d * 136 + q] = f2bf(gelu_tanh(bfs2f(v[e])) * r * p.g_gmlp[l * 256 + h * 64 + d]);
                }
            }
        }
        __syncthreads();
        f32x4 acc[2][4];
#pragma unroll
        for (int i = 0; i < 2; ++i)
#pragma unroll
            for (int nd = 0; nd < 4; ++nd) acc[i][nd] = (f32x4){0.f, 0.f, 0.f, 0.f};
#pragma unroll
        for (int ks = 0; ks < 4; ++ks) {
            bf16x8 a[2], bb[4];
#pragma unroll
            for (int i = 0; i < 2; ++i) a[i] = afr[ks][i];
#pragma unroll
            for (int nd = 0; nd < 4; ++nd) bb[nd] = *(const bf16x8*)(zT + (nd * 16 + fr) * 136 + ks * 32 + fq * 8);
#pragma unroll
            for (int i = 0; i < 2; ++i)
#pragma unroll
                for (int nd = 0; nd < 4; ++nd) acc[i][nd] = mfma16(a[i], bb[nd], acc[i][nd]);
        }
#pragma unroll
        for (int i = 0; i < 2; ++i) {
            bf16_t uraw[4][4];
            float bsv[4];
#pragma unroll
            for (int j = 0; j < 4; ++j) {
                const int pi = w * 32 + i * 16 + fq * 4 + j;
                bsv[j] = p.b_sp[(l * 4 + h) * 128 + pi];
#pragma unroll
                for (int nd = 0; nd < 4; ++nd) uraw[j][nd] = P[(size_t)(tok0 + pi) * PW + 512 + h * 64 + nd * 16 + fr];
            }
            __builtin_amdgcn_sched_barrier(0);
#pragma unroll
            for (int j = 0; j < 4; ++j) {
                const int pi = w * 32 + i * 16 + fq * 4 + j;
#pragma unroll
                for (int nd = 0; nd < 4; ++nd) {
                    const int ch = h * 64 + nd * 16 + fr;
                    const float uu = gelu_tanh(bf2f(uraw[j][nd]));
                    MIX[(size_t)(tok0 + pi) * 1024 + 256 + ch] = f2bf(uu * (acc[i][nd][j] + bsv[j]));
                }
            }
        }
    }
}

__device__ __forceinline__ void prep_unit(const Params& p, int l, int u) {
    const bf16_t* __restrict__ P = (const bf16_t*)(p.ws + OFF_P);
    bf16_t* Qc = (bf16_t*)(p.ws + OFF_QC);
    bf16_t* Kc = (bf16_t*)(p.ws + OFF_KC);
    bf16_t* KcT = (bf16_t*)(p.ws + OFF_KCT);
    const int tid = get_tid();
    const int tok0 = u * 8;
    const SeqInfo s = seqinfo(tok0);
    const bool isctx = tok0 >= NLAT;
    const int qk = tid >> 7, h = (tid >> 5) & 3, half = (tid >> 4) & 1, i = tid & 15;
    const int c1 = h * 64 + half * 32 + i, c2 = c1 + 16;
    const bf16_t* Pc = P + 1024 + qk * 256;
    const float* wc = p.w_conv + (size_t)l * 3 * 512 + qk * 256;
    const float w10 = wc[c1], w11 = wc[512 + c1], w12 = wc[1024 + c1];
    const float w20 = wc[c2], w21 = wc[512 + c2], w22 = wc[1024 + c2];
    float x1[10], x2[10];
#pragma unroll
    for (int jj = 0; jj < 10; ++jj) {
        const int tp = s.t - 1 + jj;
        const bool valid = (tp >= 0) && (tp < s.T);
        const int tpc = min(max(tp, 0), s.T - 1);
        const size_t off = (size_t)(tok0 - s.t + tpc) * PW;
        const float l1 = bf2f(Pc[off + c1]), l2 = bf2f(Pc[off + c2]);
        x1[jj] = valid ? l1 : 0.f;
        x2[jj] = valid ? l2 : 0.f;
    }
    const float inv = exp2f(-(float)i * (13.287712379549449f / 16.f));
    bf16_t o1[8], o2[8];
    bf16_t* dn = qk ? Kc : Qc;
#pragma unroll
    for (int t = 0; t < 8; ++t) {
        const float y1 = w10 * x1[t] + w11 * x1[t + 1] + w12 * x1[t + 2];
        const float y2 = w20 * x2[t] + w21 * x2[t + 1] + w22 * x2[t + 2];
        const float s1 = y1 * __builtin_amdgcn_rcpf(1.f + __expf(-y1)), s2 = y2 * __builtin_amdgcn_rcpf(1.f + __expf(-y2));
        float r1 = s1, r2 = s2;
        if (!isctx) {
            const int tp = s.t + t;
            const float pos = half ? (float)(tp & 63) : (float)(tp >> 6);
            float sn, cs;
            sincosf(pos * inv, &sn, &cs);
            r1 = s1 * cs - s2 * sn;
            r2 = s1 * sn + s2 * cs;
        }
        if (qk) { r1 *= 0.125f; r2 *= 0.125f; }
        o1[t] = f2bf(r1); o2[t] = f2bf(r2);
        dn[(size_t)(tok0 + t) * 256 + c1] = o1[t];
        dn[(size_t)(tok0 + t) * 256 + c2] = o2[t];
    }
    if (qk) {
        u32x4 a, bq;
        a.x = o1[0] | ((unsigned)o1[1] << 16); a.y = o1[2] | ((unsigned)o1[3] << 16); a.z = o1[4] | ((unsigned)o1[5] << 16); a.w = o1[6] | ((unsigned)o1[7] << 16);
        bq.x = o2[0] | ((unsigned)o2[1] << 16); bq.y = o2[2] | ((unsigned)o2[3] << 16); bq.z = o2[4] | ((unsigned)o2[5] << 16); bq.w = o2[6] | ((unsigned)o2[7] << 16);
        *(u32x4*)(KcT + s.base + (size_t)c1 * s.T + s.t) = a;
        *(u32x4*)(KcT + s.base + (size_t)c2 * s.T + s.t) = bq;
    }
}

__device__ __forceinline__ void load_gates(const Params& p, int l, int tok0, int h, int dir, float* gi, float* gf, float* bc) {
    const float* G = (const float*)(p.ws + OFF_G);
    const int tid = get_tid();
    __syncthreads();
    if (tid < 128) {
        const float* gr = G + (size_t)(tok0 + tid) * 16 + dir * 8;
        gi[tid] = gr[h] + p.b_gate[l * 16 + dir * 8 + h];
        gf[tid] = logsigmoidf_(gr[4 + h] + p.b_gate[l * 16 + dir * 8 + 4 + h]);
    }
    __syncthreads();
    if (tid < 64) {
        const int lane = get_tid();
        int t0, t1;
        if (!dir) { t0 = 2 * lane; t1 = 2 * lane + 1; } else { t0 = 127 - 2 * lane; t1 = 126 - 2 * lane; }
        const float a = gf[t0], b2 = gf[t1];
        float s = a + b2;
#pragma unroll
        for (int o = 1; o < 64; o <<= 1) { float v = shi(s, lane - o); if (lane >= o) s += v; }
        bc[t1] = s;
        bc[t0] = s - b2;
    }
    __syncthreads();
}

__device__ __forceinline__ void c1_unit(const Params& p, int l, int unit, char* lds) {
    const bf16_t* __restrict__ VTC = (const bf16_t*)(p.ws + OFF_VTC);
    const bf16_t* KcT = (const bf16_t*)(p.ws + OFF_KCT);
    float* Ub = (float*)(p.ws + OFF_UB);
    float* Usc = (float*)(p.ws + OFF_USC);
    const int tid = get_tid(), lane = tid & 63, w = tid >> 6, fr = lane & 15, fq = lane >> 4;
    const int kk = unit % 18, chain = unit / 18, dir = chain & 1, h = (chain >> 1) & 3, b = chain >> 3;
    int isctx, chunk;
    if (kk < 2) { isctx = 1; chunk = dir ? 1 - kk : kk; } else { isctx = 0; chunk = dir ? 17 - kk : kk - 2; }
    const int tok0 = isctx ? NLAT + b * 256 + chunk * 128 : b * 2048 + chunk * 128;
    const SeqInfo s = seqinfo(tok0);
    float* gi = (float*)lds; float* gf = gi + 128; float* bc = gf + 128; float* wv = bc + 128; float* sc = wv + 128;
    bf16x8 kbf[4], vaf[4][4];
#pragma unroll
    for (int ks = 0; ks < 4; ++ks) {
        const int so = ks * 32 + fq * 8;
        kbf[ks] = *(const bf16x8*)(KcT + s.base + (size_t)(h * 64 + 16 * w + fr) * s.T + s.t + so);
#pragma unroll
        for (int mt = 0; mt < 4; ++mt) vaf[ks][mt] = *(const bf16x8*)(VTC + s.base + (size_t)(h * 64 + mt * 16 + fr) * s.T + s.t + so);
    }
    {
        const float* __restrict__ G = (const float*)(p.ws + OFF_G);
        float graw_i = 0.f, graw_f = 0.f;
        if (tid < 128) { const float* gr = G + (size_t)(tok0 + tid) * 16 + dir * 8; graw_i = gr[h]; graw_f = gr[4 + h]; }
        const float bgi = p.b_gate[l * 16 + dir * 8 + h], bgf = p.b_gate[l * 16 + dir * 8 + 4 + h];
        __builtin_amdgcn_sched_barrier(0);
        __syncthreads();
        if (tid < 128) { gi[tid] = graw_i + bgi; gf[tid] = logsigmoidf_(graw_f + bgf); }
        __syncthreads();
        if (tid < 64) {
            const int ln = get_tid();
            int t0, t1;
            if (!dir) { t0 = 2 * ln; t1 = 2 * ln + 1; } else { t0 = 127 - 2 * ln; t1 = 126 - 2 * ln; }
            const float a = gf[t0], b2 = gf[t1];
            float sacc = a + b2;
#pragma unroll
            for (int o = 1; o < 64; o <<= 1) { float v = shi(sacc, ln - o); if (ln >= o) sacc += v; }
            bc[t1] = sacc; bc[t0] = sacc - b2;
        }
        __syncthreads();
    }
    const float bend = dir ? bc[0] : bc[127];
    if (tid < 64) {
        const int lane = get_tid();
        const float a0 = bend - bc[tid] + gi[tid], a1 = bend - bc[tid + 64] + gi[tid + 64];
        float m = fmaxf(a0, a1);
#pragma unroll
        for (int o = 32; o >= 1; o >>= 1) m = fmaxf(m, shx(m, o, lane));
        wv[tid] = __expf(a0 - m); wv[tid + 64] = __expf(a1 - m);
        if (tid == 0) sc[0] = m;
    }
    __syncthreads();
    f32x4 acc[5];
#pragma unroll
    for (int mt = 0; mt < 5; ++mt) acc[mt] = (f32x4){0.f, 0.f, 0.f, 0.f};
#pragma unroll
    for (int ks = 0; ks < 4; ++ks) {
        const int so = ks * 32 + fq * 8;
        const bf16x8 kb = kbf[ks];
        float wl[8];
#pragma unroll
        for (int e = 0; e < 8; ++e) wl[e] = wv[so + e];
#pragma unroll
        for (int mt = 0; mt < 4; ++mt) {
            const bf16x8 va = vaf[ks][mt];
            bf16x8 a;
#pragma unroll
            for (int e = 0; e < 8; ++e) a[e] = (short)f2bf(bfs2f(va[e]) * wl[e]);
            acc[mt] = mfma16(a, kb, acc[mt]);
        }
        bf16x8 a1;
#pragma unroll
        for (int e = 0; e < 8; ++e) a1[e] = (fr == 0) ? (short)f2bf(wl[e]) : (short)0;
        acc[4] = mfma16(a1, kb, acc[4]);
    }
#pragma unroll
    for (int mt = 0; mt < 5; ++mt)
#pragma unroll
        for (int j = 0; j < 4; ++j) Ub[(size_t)unit * 5120 + (mt * 16 + fq * 4 + j) * 64 + 16 * w + fr] = acc[mt][j];
    if (tid == 0) { Usc[unit * 2] = sc[0]; Usc[unit * 2 + 1] = bend; }
}

__device__ __forceinline__ void c2_task(const Params& p, int task) {
    const float* __restrict__ Ub = (const float*)(p.ws + OFF_UB);
    const float* __restrict__ Usc = (const float*)(p.ws + OFF_USC);
    bf16_t* __restrict__ Sb = (bf16_t*)(p.ws + OFF_SB);
    float* Mb = (float*)(p.ws + OFF_MB);
    const int tidx = get_tid();
    const int chain = task / 20, sub = task % 20, el = sub * 256 + tidx;
    float S = 0.f, m = 0.f;
    float ubv[18], mlv[18], bev[18];
#pragma unroll
    for (int kk = 0; kk < 18; ++kk) {
        const int unit = chain * 18 + kk;
        ubv[kk] = Ub[(size_t)unit * 5120 + el]; mlv[kk] = Usc[unit * 2]; bev[kk] = Usc[unit * 2 + 1];
    }
    __builtin_amdgcn_sched_barrier(0);
#pragma unroll
    for (int kk = 0; kk < 18; ++kk) {
        const int unit = chain * 18 + kk;
        Sb[(size_t)unit * 5120 + el] = f2bf(S);
        if (sub == 0 && tidx == 0) Mb[unit] = m;
        const float mloc = mlv[kk], bend = bev[kk];
        const float mnew = fmaxf(bend + m, mloc);
        S = __expf(bend + m - mnew) * S + __expf(mloc - mnew) * ubv[kk];
        m = mnew;
    }
}

__device__ __forceinline__ void c3_unit(const Params& p, int l, int b, int h, int isctx, int chunk, char* lds) {
    const bf16_t* __restrict__ P = (const bf16_t*)(p.ws + OFF_P);
    const bf16_t* __restrict__ VTC = (const bf16_t*)(p.ws + OFF_VTC);
    const bf16_t* Qc = (const bf16_t*)(p.ws + OFF_QC);
    const bf16_t* Kc = (const bf16_t*)(p.ws + OFF_KC);
    const bf16_t* Sb = (const bf16_t*)(p.ws + OFF_SB);
    const float* Mb = (const float*)(p.ws + OFF_MB);
    bf16_t* __restrict__ MIX = (bf16_t*)(p.ws + OFF_HM);
    const int tid = get_tid(), lane = tid & 63, w = tid >> 6, fr = lane & 15, fq = lane >> 4;
    const int tok0 = isctx ? NLAT + b * 256 + chunk * 128 : b * 2048 + chunk * 128;
    const SeqInfo s = seqinfo(tok0);
    float* gi = (float*)lds; float* gf = gi + 128; float* bc = gf + 128; float* av = bc + 128; float* Mx = av + 128;
    float* hsb = (float*)(lds + 4096);
    for (int dir = 0; dir < 2; ++dir) {
        const int kk = isctx ? (dir ? 1 - chunk : chunk) : (dir ? 17 - chunk : chunk + 2);
        const int unit = ((b * 4 + h) * 2 + dir) * 18 + kk;
        const float m_prev = Mb[unit];
        load_gates(p, l, tok0, h, dir, gi, gf, bc);
        if (tid < 64) {
            const int tid = get_tid();
            int t0, t1;
            if (!dir) { t0 = 2 * tid; t1 = 2 * tid + 1; } else { t0 = 127 - 2 * tid; t1 = 126 - 2 * tid; }
            const float a0 = gi[t0] - bc[t0], a1 = gi[t1] - bc[t1];
            av[t0] = a0; av[t1] = a1;
            float mm = fmaxf(a0, a1);
#pragma unroll
            for (int o = 1; o < 64; o <<= 1) { float v = shi(mm, tid - o); if (tid >= o) mm = fmaxf(mm, v); }
            float prev = shi(mm, tid - 1);
            if (tid == 0) prev = -3e38f;
            Mx[t1] = fmaxf(mm, m_prev);
            Mx[t0] = fmaxf(fmaxf(prev, a0), m_prev);
        }
        __syncthreads();
#pragma unroll 1
        for (int ti = 0; ti < 2; ++ti) {
            const int trow = w * 32 + ti * 16;
            const int tt = trow + fr;
            const bf16_t* qp = Qc + (size_t)(tok0 + tt) * 256 + h * 64 + fq * 8;
            const bf16x8 q0 = *(const bf16x8*)qp, q1 = *(const bf16x8*)(qp + 32);
            const float Mt = Mx[tt];
            bf16x8 ka[8][2], vbf[4][4];
#pragma unroll
            for (int st = 0; st < 8; ++st) {
                const bf16_t* kp = Kc + (size_t)(tok0 + st * 16 + fr) * 256 + h * 64 + fq * 8;
                ka[st][0] = *(const bf16x8*)kp; ka[st][1] = *(const bf16x8*)(kp + 32);
            }
            __builtin_amdgcn_sched_barrier(0);
            f32x4 wt[8];
            float dsum = 0.f;
#pragma unroll
            for (int st = 0; st < 8; ++st) {
                f32x4 acc = (f32x4){0.f, 0.f, 0.f, 0.f};
                acc = mfma16(ka[st][0], q0, acc);
                acc = mfma16(ka[st][1], q1, acc);
#pragma unroll
                for (int j = 0; j < 4; ++j) {
                    const int ss = st * 16 + fq * 4 + j;
                    const bool ok = dir ? (ss >= tt) : (ss <= tt);
                    const float wg = ok ? __expf(av[ss] - Mt) : 0.f;
                    const float v = acc[j] * wg;
                    wt[st][j] = v; dsum += v;
                }
            }
#pragma unroll
            for (int i = 0; i < 4; ++i)
#pragma unroll
                for (int ne = 0; ne < 4; ++ne) {
                    const bf16_t* vp = VTC + s.base + (size_t)(h * 64 + ne * 16 + fr) * s.T + s.t + i * 32 + 4 * fq;
                    vbf[i][ne] = cat4(*(const bf16x4*)vp, *(const bf16x4*)(vp + 16));
                }
            bf16x8 sbf[5][2];
#pragma unroll
            for (int ne = 0; ne < 5; ++ne) {
                const bf16_t* sp = Sb + (size_t)unit * 5120 + (ne * 16 + fr) * 64 + fq * 8;
                sbf[ne][0] = *(const bf16x8*)sp; sbf[ne][1] = *(const bf16x8*)(sp + 32);
            }
            __builtin_amdgcn_sched_barrier(0);
            dsum += shx(dsum, 16, lane);
            dsum += shx(dsum, 32, lane);
            f32x4 nm[4];
#pragma unroll
            for (int ne = 0; ne < 4; ++ne) nm[ne] = (f32x4){0.f, 0.f, 0.f, 0.f};
#pragma unroll
            for (int i = 0; i < 4; ++i) {
                const bf16x8 pa = packw(wt[2 * i], wt[2 * i + 1]);
#pragma unroll
                for (int ne = 0; ne < 4; ++ne) nm[ne] = mfma16(pa, vbf[i][ne], nm[ne]);
            }
            f32x4 qc[5];
#pragma unroll
            for (int ne = 0; ne < 5; ++ne) {
                f32x4 a = (f32x4){0.f, 0.f, 0.f, 0.f};
                a = mfma16(q0, sbf[ne][0], a);
                a = mfma16(q1, sbf[ne][1], a);
                qc[ne] = a;
            }
            f32x4 hv[4];
#pragma unroll
            for (int j = 0; j < 4; ++j) {
                const int tl = fq * 4 + j, t = trow + tl;
                const float Mv = Mx[t];
                const float wi = __expf(m_prev - Mv);
                const float mt_ = bc[t] + Mv;
                const float den = shi(dsum, tl) + wi * shi(qc[4][j], lane & 48);
                const float dn = fmaxf(fabsf(den), __expf(-mt_));
                const float idn = __builtin_amdgcn_rcpf(dn);
#pragma unroll
                for (int ne = 0; ne < 4; ++ne) hv[ne][j] = (nm[ne][j] + wi * qc[ne][j]) * idn;
            }
            if (dir == 0) {
#pragma unroll
                for (int ne = 0; ne < 4; ++ne)
#pragma unroll
                    for (int j = 0; j < 4; ++j) hsb[(ti * 16 + ne * 4 + j) * 256 + tid] = hv[ne][j];
            } else {
#pragma unroll
                for (int ne = 0; ne < 4; ++ne)
#pragma unroll
                    for (int j = 0; j < 4; ++j) hv[ne][j] += hsb[(ti * 16 + ne * 4 + j) * 256 + tid];
                bf16_t ograw[4][4];
#pragma unroll
                for (int j = 0; j < 4; ++j)
#pragma unroll
                    for (int ne = 0; ne < 4; ++ne) ograw[j][ne] = P[(size_t)(tok0 + trow + fq * 4 + j) * PW + 1536 + h * 64 + ne * 16 + fr];
                __builtin_amdgcn_sched_barrier(0);
#pragma unroll
                for (int j = 0; j < 4; ++j) {
                    const int t = trow + fq * 4 + j;
                    float sm = hv[0][j] + hv[1][j] + hv[2][j] + hv[3][j];
#pragma unroll
                    for (int o = 1; o < 16; o <<= 1) sm += shx(sm, o, lane);
                    const float mu = sm * (1.f / 64.f);
                    float vr = 0.f;
#pragma unroll
                    for (int ne = 0; ne < 4; ++ne) { float dlt = hv[ne][j] - mu; vr += dlt * dlt; }
#pragma unroll
                    for (int o = 1; o < 16; o <<= 1) vr += shx(vr, o, lane);
                    const float rstd = rsqrtf(vr * (1.f / 64.f) + 1e-6f);
#pragma unroll
                    for (int ne = 0; ne < 4; ++ne) {
                        const int e = h * 64 + ne * 16 + fr;
                        const float y = (hv[ne][j] - mu) * rstd * p.g_mlstm[l * 256 + e];
                        const float og = sigmoidf_(bf2f(ograw[j][ne]));
                        MIX[(size_t)(tok0 + t) * 1024 + 512 + e] = f2bf(og * y);
                    }
                }
            }
        }
    }
}


__device__ __forceinline__ void c3_unit2(const Params& p, int l, int b, int h, int isctx, int chunk, char* lds) {
    const bf16_t* __restrict__ P = (const bf16_t*)(p.ws + OFF_P);
    const bf16_t* __restrict__ VTC = (const bf16_t*)(p.ws + OFF_VTC);
    const bf16_t* __restrict__ Qc = (const bf16_t*)(p.ws + OFF_QC);
    const bf16_t* __restrict__ Kc = (const bf16_t*)(p.ws + OFF_KC);
    const bf16_t* __restrict__ Sb = (const bf16_t*)(p.ws + OFF_SB);
    const float* __restrict__ Mb = (const float*)(p.ws + OFF_MB);
    const float* __restrict__ G = (const float*)(p.ws + OFF_G);
    bf16_t* __restrict__ MIX = (bf16_t*)(p.ws + OFF_HM);
    const int tid = get_tid(), lane = tid & 63, w = __builtin_amdgcn_readfirstlane(tid >> 6), fr = lane & 15, fq = lane >> 4;
    const int tok0 = isctx ? NLAT + b * 256 + chunk * 128 : b * 2048 + chunk * 128;
    const SeqInfo s = seqinfo(tok0);
    float* gi = (float*)lds; float* gf = gi + 128; float* bc = gf + 128; float* av = bc + 128; float* Mx = av + 128;
    float* hsb = (float*)(lds + 4096);
    const char* kst = lds + 36864;
    const char* vst = lds + 53248;
    const unsigned lbase = (unsigned)(size_t)(lds_ptr_t)lds;
    __syncthreads();
#pragma unroll
    for (int i = 0; i < 4; ++i) {
        const int pc = w * 4 + i;
        const int sc = (lane & 7) ^ (((pc & 1) * 4 + (lane >> 4)) & 7);
        glds16((const void*)(Kc + (size_t)(tok0 + pc * 8 + (lane >> 3)) * 256 + h * 64 + sc * 8), lbase + 36864 + pc * 1024);
    }
#pragma unroll
    for (int i = 0; i < 4; ++i) {
        const int pc = w * 4 + i;
        const int e = pc * 4 + (lane >> 4), cp = lane & 15;
        glds16((const void*)(VTC + s.base + (size_t)(h * 64 + e) * s.T + s.t + ((cp ^ (e & 15)) << 3)), lbase + 53248 + pc * 1024);
    }
    for (int dir = 0; dir < 2; ++dir) {
        const int kk = isctx ? (dir ? 1 - chunk : chunk) : (dir ? 17 - chunk : chunk + 2);
        const int unit = ((b * 4 + h) * 2 + dir) * 18 + kk;
        const float m_prev = Mb[unit];
        float graw_i = 0.f, graw_f = 0.f;
        if (tid < 128) { const float* gr = G + (size_t)(tok0 + tid) * 16 + dir * 8; graw_i = gr[h]; graw_f = gr[4 + h]; }
        bf16x8 qf[2][2], sbf[5][2];
#pragma unroll
        for (int ti = 0; ti < 2; ++ti) {
            const bf16_t* qp = Qc + (size_t)(tok0 + w * 32 + ti * 16 + fr) * 256 + h * 64 + fq * 8;
            qf[ti][0] = *(const bf16x8*)qp; qf[ti][1] = *(const bf16x8*)(qp + 32);
        }
#pragma unroll
        for (int ne = 0; ne < 5; ++ne) {
            const bf16_t* sp = Sb + (size_t)unit * 5120 + (ne * 16 + fr) * 64 + fq * 8;
            sbf[ne][0] = *(const bf16x8*)sp; sbf[ne][1] = *(const bf16x8*)(sp + 32);
        }
        const float bgi = p.b_gate[l * 16 + dir * 8 + h], bgf = p.b_gate[l * 16 + dir * 8 + 4 + h];
        __builtin_amdgcn_sched_barrier(0);
        __syncthreads();
        if (tid < 128) { gi[tid] = graw_i + bgi; gf[tid] = logsigmoidf_(graw_f + bgf); }
        __syncthreads();
        if (tid < 64) {
            const int ln = get_tid();
            int t0, t1;
            if (!dir) { t0 = 2 * ln; t1 = 2 * ln + 1; } else { t0 = 127 - 2 * ln; t1 = 126 - 2 * ln; }
            const float a = gf[t0], b2 = gf[t1];
            float sacc = a + b2;
#pragma unroll
            for (int o = 1; o < 64; o <<= 1) { float v = shi(sacc, ln - o); if (ln >= o) sacc += v; }
            const float bc1 = sacc, bc0 = sacc - b2;
            bc[t1] = bc1; bc[t0] = bc0;
            const float a0 = gi[t0] - bc0, a1 = gi[t1] - bc1;
            av[t0] = a0; av[t1] = a1;
            float mm = fmaxf(a0, a1);
#pragma unroll
            for (int o = 1; o < 64; o <<= 1) { float v = shi(mm, ln - o); if (ln >= o) mm = fmaxf(mm, v); }
            float prev = shi(mm, ln - 1);
            if (ln == 0) prev = -3e38f;
            Mx[t1] = fmaxf(mm, m_prev);
            Mx[t0] = fmaxf(fmaxf(prev, a0), m_prev);
        }
        asm volatile("s_waitcnt vmcnt(0)" ::: "memory");
        __syncthreads();
#pragma unroll
        for (int ti = 0; ti < 2; ++ti) {
            const int trow = w * 32 + ti * 16;
            const int tt = trow + fr;
            const bf16x8 q0 = qf[ti][0], q1 = qf[ti][1];
            const float Mt = Mx[tt];
            f32x4 nm[4];
#pragma unroll
            for (int ne = 0; ne < 4; ++ne) nm[ne] = (f32x4){0.f, 0.f, 0.f, 0.f};
            float dsum = 0.f;
#pragma unroll
            for (int hf = 0; hf < 2; ++hf) {
                f32x4 wt[4];
#pragma unroll
                for (int s4 = 0; s4 < 4; ++s4) {
                    const int st = hf * 4 + s4;
                    const int tokidx = st * 16 + fr, sw = (tokidx >> 1) & 7;
                    const bf16x8 k0 = *(const bf16x8*)(kst + tokidx * 128 + ((fq ^ sw) << 4));
                    const bf16x8 k1 = *(const bf16x8*)(kst + tokidx * 128 + (((4 + fq) ^ sw) << 4));
                    f32x4 acc = (f32x4){0.f, 0.f, 0.f, 0.f};
                    acc = mfma16(k0, q0, acc);
                    acc = mfma16(k1, q1, acc);
#pragma unroll
                    for (int j = 0; j < 4; ++j) {
                        const int ss = st * 16 + fq * 4 + j;
                        const bool ok = dir ? (ss >= tt) : (ss <= tt);
                        const float wg = ok ? __expf(av[ss] - Mt) : 0.f;
                        const float v = acc[j] * wg;
                        wt[s4][j] = v; dsum += v;
                    }
                }
#pragma unroll
                for (int i2 = 0; i2 < 2; ++i2) {
                    const int i = hf * 2 + i2;
                    const bf16x8 pa = packw(wt[2 * i2], wt[2 * i2 + 1]);
                    const int tl = i * 32 + 4 * fq, tl2 = tl + 16;
#pragma unroll
                    for (int ne = 0; ne < 4; ++ne) {
                        const int e = ne * 16 + fr;
                        const char* row = vst + e * 256;
                        const bf16x4 v0 = *(const bf16x4*)(row + (((tl >> 3) ^ (e & 15)) << 4) + (tl & 7) * 2);
                        const bf16x4 v1 = *(const bf16x4*)(row + (((tl2 >> 3) ^ (e & 15)) << 4) + (tl2 & 7) * 2);
                        nm[ne] = mfma16(pa, cat4(v0, v1), nm[ne]);
                    }
                }
            }
            dsum += shx(dsum, 16, lane);
            dsum += shx(dsum, 32, lane);
            f32x4 qc[5];
#pragma unroll
            for (int ne = 0; ne < 5; ++ne) {
                f32x4 a = (f32x4){0.f, 0.f, 0.f, 0.f};
                a = mfma16(q0, sbf[ne][0], a);
                a = mfma16(q1, sbf[ne][1], a);
                qc[ne] = a;
            }
            f32x4 hv[4];
#pragma unroll
            for (int j = 0; j < 4; ++j) {
                const int tl = fq * 4 + j, t = trow + tl;
                const float Mv = Mx[t];
                const float wi = __expf(m_prev - Mv);
                const float mt_ = bc[t] + Mv;
                const float den = shi(dsum, tl) + wi * shi(qc[4][j], lane & 48);
                const float dn = fmaxf(fabsf(den), __expf(-mt_));
                const float idn = __builtin_amdgcn_rcpf(dn);
#pragma unroll
                for (int ne = 0; ne < 4; ++ne) hv[ne][j] = (nm[ne][j] + wi * qc[ne][j]) * idn;
            }
            if (dir == 0) {
#pragma unroll
                for (int ne = 0; ne < 4; ++ne)
#pragma unroll
                    for (int j = 0; j < 4; ++j) hsb[(ti * 16 + ne * 4 + j) * 256 + tid] = hv[ne][j];
            } else {
                bf16_t ograw[4][4];
#pragma unroll
                for (int j = 0; j < 4; ++j)
#pragma unroll
                    for (int ne = 0; ne < 4; ++ne) ograw[j][ne] = P[(size_t)(tok0 + trow + fq * 4 + j) * PW + 1536 + h * 64 + ne * 16 + fr];
                __builtin_amdgcn_sched_barrier(0);
#pragma unroll
                for (int ne = 0; ne < 4; ++ne)
#pragma unroll
                    for (int j = 0; j < 4; ++j) hv[ne][j] += hsb[(ti * 16 + ne * 4 + j) * 256 + tid];
#pragma unroll
                for (int j = 0; j < 4; ++j) {
                    const int t = trow + fq * 4 + j;
                    float sm = hv[0][j] + hv[1][j] + hv[2][j] + hv[3][j];
#pragma unroll
                    for (int o = 1; o < 16; o <<= 1) sm += shx(sm, o, lane);
                    const float mu = sm * (1.f / 64.f);
                    float vr = 0.f;
#pragma unroll
                    for (int ne = 0; ne < 4; ++ne) { float dlt = hv[ne][j] - mu; vr += dlt * dlt; }
#pragma unroll
                    for (int o = 1; o < 16; o <<= 1) vr += shx(vr, o, lane);
                    const float rstd = rsqrtf(vr * (1.f / 64.f) + 1e-6f);
#pragma unroll
                    for (int ne = 0; ne < 4; ++ne) {
                        const int e = h * 64 + ne * 16 + fr;
                        const float y = (hv[ne][j] - mu) * rstd * p.g_mlstm[l * 256 + e];
                        const float og = sigmoidf_(bf2f(ograw[j][ne]));
                        MIX[(size_t)(tok0 + t) * 1024 + 512 + e] = f2bf(og * y);
                    }
                }
            }
        }
    }
}

#define XB_TMO      128
#define XB_XCNT(j)  (256  + 64 * (j))
#define XB_XSUB(j)  (1280 + 64 * (j))
#define XB_XGEN(j)  (2304 + 64 * (j))
#define XB_TOP      3328
#define XB_TOPGEN   3392
#define XCD_BAR_WORDS 3456
#define XB_SPIN_CAP (1u << 22)
#define LAS __attribute__((address_space(3)))
__device__ __forceinline__ unsigned xb_ld(unsigned* p) { return __hip_atomic_load(p, __ATOMIC_RELAXED, __HIP_MEMORY_SCOPE_AGENT); }
__device__ __forceinline__ unsigned xb_add(unsigned* p, unsigned v) { return __hip_atomic_fetch_add(p, v, __ATOMIC_RELAXED, __HIP_MEMORY_SCOPE_AGENT); }
__device__ __forceinline__ unsigned xb_xcc_id() { return (unsigned)__builtin_amdgcn_s_getreg((3 << 11) | 20) & 0xFu; }
#define XB_SPIN(cond, bar) do { unsigned _sp = 0; while (cond) { __builtin_amdgcn_s_sleep(1); \
    if ((++_sp & 255u) == 0u) { if (xb_ld(&(bar)[XB_TMO])) break; if (_sp > XB_SPIN_CAP) { atomicAdd(&(bar)[XB_TMO], 1u); break; } } } } while (0)
struct XcdBarrier { unsigned* bar; unsigned x; volatile LAS unsigned* st; };
__device__ __forceinline__ XcdBarrier xcd_barrier_post(unsigned* bar, volatile LAS unsigned* st) {
    XcdBarrier b; b.bar = bar; b.x = xb_xcc_id(); b.st = st;
    if (threadIdx.x == 0) (void)xb_add(&bar[XB_XCNT(b.x)], 1u);
    return b;
}
__device__ __forceinline__ void xcd_barrier_complete(unsigned* bar, unsigned x, unsigned& nloc, unsigned& nx) {
    const unsigned G = gridDim.x * gridDim.y * gridDim.z;
    unsigned sum, cnt, mine, sp = 0u;
    for (;;) {
        sum = 0u; cnt = 0u; mine = 0u;
#pragma unroll
        for (unsigned j = 0; j < 16; ++j) { const unsigned c = xb_ld(&bar[XB_XCNT(j)]); sum += c; cnt += (c > 0u) ? 1u : 0u; mine = (j == x) ? c : mine; }
        if (sum == G) break;
        __builtin_amdgcn_s_sleep(1);
        if ((++sp & 255u) == 0u) { if (xb_ld(&bar[XB_TMO])) break; if (sp > XB_SPIN_CAP) { atomicAdd(&bar[XB_TMO], 1u); break; } }
    }
    nloc = mine > 0u ? mine : 1u; nx = cnt > 0u ? cnt : 1u;
}
__device__ __forceinline__ void xcd_barrier(const XcdBarrier& b) {
    asm volatile("s_waitcnt vmcnt(0)" ::: "memory");
    __syncthreads();
    if (threadIdx.x == 0) {
        unsigned* bar = b.bar;
        __builtin_amdgcn_s_waitcnt(0);
        unsigned nloc = b.st[0], nx = b.st[1];
        if (nloc == 0u) { xcd_barrier_complete(bar, b.x, nloc, nx); b.st[0] = nloc; b.st[1] = nx; }
        const unsigned old = xb_add(&bar[XB_XSUB(b.x)], 1u);
        const unsigned gen = old / nloc;
        if (old + 1u == (gen + 1u) * nloc) {
            __builtin_amdgcn_fence(__ATOMIC_RELEASE, "agent");
            asm volatile("s_waitcnt vmcnt(0)" ::: "memory");
            const unsigned og = xb_add(&bar[XB_TOP], 1u);
            const unsigned tg = og / nx;
            if (og + 1u == (tg + 1u) * nx) xb_add(&bar[XB_TOPGEN], 1u);
            else XB_SPIN(xb_ld(&bar[XB_TOPGEN]) == tg, bar);
            __builtin_amdgcn_fence(__ATOMIC_ACQUIRE, "agent");
            xb_add(&bar[XB_XGEN(b.x)], 1u);
            asm volatile("s_waitcnt vmcnt(0)" ::: "memory");
        } else {
            XB_SPIN(xb_ld(&bar[XB_XGEN(b.x)]) == gen, bar);
            __builtin_amdgcn_fence(__ATOMIC_ACQUIRE, "agent");
            asm volatile("s_waitcnt vmcnt(0)" ::: "memory");
        }
    }
    __syncthreads();
}
__device__ __forceinline__ bool tile_map(int it, int MT, int NT, int& mt, int& nt) {
    const int xcd = blockIdx.x & 7, j = blockIdx.x >> 3, SR = (int)(gridDim.x >> 6);
    const int ncg = (NT + 7) >> 3, nrg = (MT + SR - 1) / SR;
    const int s = xcd + 8 * it;
    if (s >= nrg * ncg) return false;
    const int rg = s / ncg, cgi = s - rg * ncg;
    mt = rg * SR + (j >> 3); nt = cgi * 8 + (j & 7);
    return true;
}

__device__ __forceinline__ bool next_tile(int& it, int MT, int NT, int& mt, int& nt) {
    while (tile_map(it, MT, NT, mt, nt)) { if (mt < MT && nt < NT) return true; ++it; }
    return false;
}
#ifndef REP_GEMM
#define REP_GEMM 1
#endif
#ifndef REP_MIX
#define REP_MIX 1
#endif
#ifndef RA
#define RA 1
#endif
#ifndef RG
#define RG 1
#endif
#ifndef RP
#define RP 1
#endif
#ifndef REP_C3
#define REP_C3 1
#endif
#ifndef REP_NORM
#define REP_NORM 1
#endif
#ifndef REP_PRO
#define REP_PRO 1
#endif
#ifndef REP_MISC
#define REP_MISC 1
#endif
__global__ void __launch_bounds__(NTHREADS, 2) mega_kernel(Params p) {
    cg::grid_group grid = cg::this_grid();
    extern __shared__ __attribute__((aligned(16))) char lds[];
    const int nblk = gridDim.x, bid = blockIdx.x;
    if (threadIdx.x == 0) { *(u32x4*)(lds + LDS_BYTES) = (u32x4){0u, 0u, 0u, 0u}; }
    __syncthreads();
    XcdBarrier xb = xcd_barrier_post((unsigned*)(p.ws + OFF_BAR), (volatile LAS unsigned*)(lds + LDS_BYTES));
    bf16_t* WinT = (bf16_t*)(p.ws + OFF_WIN);
    bf16_t* WoutT = (bf16_t*)(p.ws + OFF_WOUT);
    bf16_t* W1T = (bf16_t*)(p.ws + OFF_W1);
    bf16_t* W2T = (bf16_t*)(p.ws + OFF_W2);
    bf16_t* HM = (bf16_t*)(p.ws + OFF_HM);
    float* ctxres = (float*)(p.ws + OFF_CTXRES);
    const float* modall = (const float*)(p.ws + OFF_MOD);

    for (int rep = 0; rep < REP_PRO; ++rep) {
    prologue_phase(p, lds);
    if (p.ws == nullptr) grid.sync();
    xcd_barrier(xb);
    }
    for (int l = 0; l < 2; ++l) {
        const bool last = (l == 1);
        const float* srcLat = l == 0 ? p.x : p.out;
        const float* srcCtx = l == 0 ? p.ctx : ctxres;
        for (int rep = 0; rep < REP_NORM; ++rep) {
        norm_phase(p, l, srcLat, srcCtx, p.g_mix + l * 1024, 0, 1, NTOK, l == 1 ? (const float*)(p.ws + OFF_CPART) : nullptr);
        xcd_barrier(xb);
        }
        for (int rep = 0; rep < REP_GEMM; ++rep) {
            EpiIn epi;
            epi.P = (bf16_t*)(p.ws + OFF_P); epi.VTA = (bf16_t*)(p.ws + OFF_VTA); epi.VTC = (bf16_t*)(p.ws + OFF_VTC);
            epi.FT = (bf16_t*)(p.ws + OFF_FT); epi.G = (float*)(p.ws + OFF_G);
            const int nbx = (int)(gridDim.x >> 3), xg = bid & 7, jb = bid >> 3;
            constexpr int TOT = (NTOK / 256) * 23, PERX = TOT / 8;
            const int nround = PERX / nbx, nrem = PERX - nround * nbx;
            auto tile_of = [&](int idx, int& tm, int& tn) {
                const int g = xg * PERX + idx, rg = g / 184; int r = g - rg * 184;
                if (r < 128) { tm = rg * 8 + ((r & 63) >> 3); tn = (r >> 6) * 8 + (r & 7); }
                else { r -= 128; tm = rg * 8 + r / 7; tn = 16 + r % 7; }
            };
            const bf16_t* Wl = WinT + (size_t)l * NPAD * 1024;
            bool pref = false;
            for (int rd = 0; rd < nround; ++rd) {
                int mt, nt, mt2 = 0, nt2 = 0;
                tile_of(rd * nbx + jb, mt, nt);
                const bool have2 = (rd + 1 < nround);
                if (have2) tile_of((rd + 1) * nbx + jb, mt2, nt2);
                if (nt >= 14 && nt < 22) gemm_tile_ring<8, false>(HM, 1024, Wl, 1024, 1024, mt * 256, nt * 128, lds, epi, pref, have2, mt2 * 256, nt2 * 128);
                else gemm_tile_ring<8, true>(HM, 1024, Wl, 1024, 1024, mt * 256, nt * 128, lds, epi, pref, have2, mt2 * 256, nt2 * 128);
                pref = have2;
            }
            for (int sidx = jb; sidx < 2 * nrem; sidx += nbx) {
                int mt, nt;
                tile_of(nround * nbx + (sidx >> 1), mt, nt);
                const int m0s = mt * 256 + (sidx & 1) * 128;
                if (nt >= 14 && nt < 22) gemm_tile_ring<4, false>(HM, 1024, Wl, 1024, 1024, m0s, nt * 128, lds, epi, false, false, 0, 0);
                else gemm_tile_ring<4, true>(HM, 1024, Wl, 1024, 1024, m0s, nt * 128, lds, epi, false, false, 0, 0);
            }
            xcd_barrier(xb);
        }
        {
            const int n_dft = 256, n_gmlp = last ? 256 : 288, n_attn = 2048, n_attc = last ? 0 : 256, n_dftc = last ? 0 : 64, n_mid = 64, n_prep = NTOK / 32;
            const int e1 = n_dft, e2 = e1 + n_gmlp, e3 = e2 + n_attn, e4 = e3 + n_attc, e5 = e4 + n_dftc, e6 = e5 + n_mid, e7 = e6 + n_prep;
            unsigned* qctr = (unsigned*)(p.ws + OFF_BAR) + 3456 + l;
            int* slot = (int*)(lds + LDS_BYTES - 16);
            for (;;) {
                __syncthreads();
                if (threadIdx.x == 0) *slot = (int)atomicAdd(qctr, 1u);
                __syncthreads();
                const int t = *slot;
                if (t >= e7) break;
                if (t < e1) {
                    const int xq = t & 7, jq = t >> 3, b = 2 * xq + (jq >> 4), mt = (jq >> 1) & 7, nt = jq & 1;
                    dft_sym_tile((const bf16_t*)(p.ws + OFF_TABL), (const bf16_t*)(p.ws + OFF_FT) + (size_t)b * 256 * 4096, HM, b, mt * 128, nt * 128, 0.00276213586400995f, lds);
                } else if (t < e2) gmlp_unit(p, l, t - e1, lds);
                else if (t < e3) attn_unit2<false>(p, l, t - e2, lds);
                else if (t < e4) attn_unit2<true>(p, l, t - e3, lds);
                else if (t < e5) {
                    const int q = t - e4, b = q >> 2, mt = (q >> 1) & 1, nt = q & 1;
                    EpiDFT epi; epi.MIX = HM; epi.tok0 = NLAT + b * 256; epi.scale = 0.0078125f;
                    gemm_tile<true>((const bf16_t*)(p.ws + OFF_TABC), 512, (const bf16_t*)(p.ws + OFF_FT) + (size_t)NLAT * 512 + (size_t)b * 256 * 512, 512, 512, mt * 128, nt * 128, lds, epi);
                } else if (t < e6) dft_mid_task((const bf16_t*)(p.ws + OFF_FT), HM, t - e5, 0.00276213586400995f);
                else { const int q = t - e6; for (int u4 = 0; u4 < 4; ++u4) prep_unit(p, l, q * 4 + u4); }
            }
            xcd_barrier(xb);
        }
        for (int rep = 0; rep < REP_MISC; ++rep) {
        for (int t = bid; t < NU; t += nblk) c1_unit(p, l, t, lds);
        xcd_barrier(xb);
        for (int t = bid; t < 128 * 20; t += nblk) c2_task(p, t);
        xcd_barrier(xb);
        }
        for (int rep = 0; rep < REP_C3; ++rep) {
            const int nun = last ? 64 * 16 : 64 * 18;
            for (int t = bid; t < nun; t += nblk) {
                int b, h, isctx, chunk;
                if (t < 1024) { b = t >> 6; h = (t >> 4) & 3; isctx = 0; chunk = t & 15; }
                else { const int q = t - 1024; b = q >> 3; h = (q >> 1) & 3; isctx = 1; chunk = q & 1; }
                c3_unit2(p, l, b, h, isctx, chunk, lds);
            }
            xcd_barrier(xb);
        }
        const int Mrows = last ? NLAT : NTOK;
        {
            EpiRes epi; epi.srcLat = srcLat; epi.srcCtx = srcCtx; epi.dstLat = p.out; epi.dstCtx = ctxres;
            epi.mod = modall + (size_t)l * 17 * 6144; epi.gidx = 2;
            int it = 0, mt, nt; bool have = next_tile(it, NLAT / 256, 8, mt, nt), pref = false;
            while (have) {
                int it2 = it + 1, mt2 = 0, nt2 = 0; const bool have2 = next_tile(it2, NLAT / 256, 8, mt2, nt2);
                gemm_tile_ring<8, true>(HM, 1024, WoutT + (size_t)l * 1024 * 1024, 1024, 1024, mt * 256, nt * 128, lds, epi, pref, have2, mt2 * 256, nt2 * 128);
                pref = have2; have = have2; it = it2; mt = mt2; nt = nt2;
            }
            if (!last) {
                int itc = 0, mtc, ntc;
                while (next_tile(itc, NCTX / 64, 8, mtc, ntc)) {
                    gemm_tile_ring<2, true>(HM, 1024, WoutT + (size_t)l * 1024 * 1024, 1024, 1024, NLAT + mtc * 64, ntc * 128, lds, epi, false, false, 0, 0);
                    ++itc;
                }
            }
        }
        xcd_barrier(xb);
        for (int rep = 0; rep < REP_NORM; ++rep) {
        norm_phase(p, l, p.out, ctxres, p.g_ffn + l * 1024, 3, 4, Mrows);
        xcd_barrier(xb);
        }
        for (int rep = 0; rep < REP_GEMM; ++rep) {
            EpiFF1 epi; epi.HID = (bf16_t*)(p.ws + OFF_HID);
            int it = 0, mt, nt; bool have = next_tile(it, Mrows / 256, 32, mt, nt), pref = false;
            while (have) {
                int it2 = it + 1, mt2 = 0, nt2 = 0; const bool have2 = next_tile(it2, Mrows / 256, 32, mt2, nt2);
                gemm_tile_ring<8, true>(HM, 1024, W1T + (size_t)l * 4096 * 1024, 1024, 1024, mt * 256, nt * 128, lds, epi, pref, have2, mt2 * 256, nt2 * 128);
                pref = have2; have = have2; it = it2; mt = mt2; nt = nt2;
            }
            xcd_barrier(xb);
        }
        {
            EpiRes epi; epi.srcLat = p.out; epi.srcCtx = ctxres; epi.dstLat = p.out; epi.dstCtx = ctxres;
            epi.mod = modall + (size_t)l * 17 * 6144; epi.gidx = 5;
            int it = 0, mt, nt; bool have = next_tile(it, NLAT / 256, 8, mt, nt), pref = false;
            while (have) {
                int it2 = it + 1, mt2 = 0, nt2 = 0; const bool have2 = next_tile(it2, NLAT / 256, 8, mt2, nt2);
                gemm_tile_ring<8, true>((const bf16_t*)(p.ws + OFF_HID), 4096, W2T + (size_t)l * 1024 * 4096, 4096, 4096, mt * 256, nt * 128, lds, epi, pref, have2, mt2 * 256, nt2 * 128);
                pref = have2; have = have2; it = it2; mt = mt2; nt = nt2;
            }
            if (!last) {
                int itc = 0, mtc, ntc;
                EpiPart epart; epart.part = (float*)(p.ws + OFF_CPART); epart.mod = modall + (size_t)l * 17 * 6144; epart.gidx = 5;
                while (next_tile(itc, 64, 8, mtc, ntc)) {
                    const int kh = mtc >> 5, mrow = NLAT + (mtc & 31) * 128;
                    const bf16_t* Ah = (const bf16_t*)(p.ws + OFF_HID) + kh * 2048;
                    const bf16_t* Bh = W2T + (size_t)l * 1024 * 4096 + kh * 2048;
                    if (kh == 0) gemm_tile_ring<4, true>(Ah, 4096, Bh, 4096, 2048, mrow, ntc * 128, lds, epi, false, false, 0, 0);
                    else gemm_tile_ring<4, true>(Ah, 4096, Bh, 4096, 2048, mrow, ntc * 128, lds, epart, false, false, 0, 0);
                    ++itc;
                }
            }
        }
        xcd_barrier(xb);
    }
    final_norm_phase(p);
}

extern "C" void kernel_launch(void* const* d_in, const int* in_sizes, int n_in, void* d_out, int out_size, void* d_ws, size_t ws_size,
                              hipStream_t stream) {
    static int grid_blocks = 0;
    if (!grid_blocks) {
        int dev = 0, cus = 0, per_cu = 0;
        (void)hipGetDevice(&dev);
        (void)hipDeviceGetAttribute(&cus, hipDeviceAttributeMultiprocessorCount, dev);
        (void)hipFuncSetAttribute((const void*)mega_kernel, hipFuncAttributeMaxDynamicSharedMemorySize, LDS_BYTES + 16);
        (void)hipOccupancyMaxActiveBlocksPerMultiprocessor(&per_cu, mega_kernel, NTHREADS, LDS_BYTES + 16);
        if (per_cu > 2) per_cu = 2;
        if (per_cu < 1) per_cu = 1;
        grid_blocks = cus * per_cu;
    }
    Params p{};
    p.x = (const float*)d_in[0]; p.c = (const float*)d_in[1]; p.ctx = (const float*)d_in[2]; p.c_ctx = (const float*)d_in[3];
    p.w_ada = (const float*)d_in[4]; p.b_ada = (const float*)d_in[5]; p.g_mix = (const float*)d_in[6]; p.g_ffn = (const float*)d_in[7];
    p.w_in = (const float*)d_in[8]; p.b_gate = (const float*)d_in[9]; p.w_conv = (const float*)d_in[10]; p.rpb = (const float*)d_in[11];
    p.w_sp = (const float*)d_in[12]; p.b_sp = (const float*)d_in[13]; p.g_gmlp = (const float*)d_in[14]; p.g_mlstm = (const float*)d_in[15];
    p.w_fnet = (const float*)d_in[16]; p.w_out = (const float*)d_in[17]; p.w_ff1 = (const float*)d_in[18]; p.w_ff2 = (const float*)d_in[19];
    p.g_final = (const float*)d_in[20];
    p.out = (float*)d_out;
    p.ws = (char*)d_ws;
    (void)hipMemsetAsync((char*)d_ws + OFF_BAR, 0, 3520 * 4, stream);
    void* args[] = {&p};
    hipError_t e = hipLaunchCooperativeKernel((void*)mega_kernel, dim3(grid_blocks), dim3(NTHREADS), args, LDS_BYTES + 16, stream);
    if (e != hipSuccess) fprintf(stderr, "cooperative launch failed: %s (grid %d)\n", hipGetErrorString(e), grid_blocks);
}
```
